# Optimizing an MI355X kernel written in HIP

```python
import jax
import jax.numpy as jnp
from jax import lax
import numpy as np

D_MODEL = 1024
BATCH = 32
SEQ = 256
DEPTH = 4
DEC_BATCH = 2
DEC_SEQ = 2048
PAST_LEN = 256

GRID_W = 64
N_MIXERS = 3
N_MLA = (DEPTH + 2) // 3
N_HGRN = (DEPTH + 1) // 3
N_SWA = DEPTH // 3

MLA_HEADS = 8
MLA_Q_LORA = 512
MLA_KV_LORA = 256
MLA_NOPE_DIM = 128
MLA_ROPE_DIM = 64
MLA_V_DIM = 128
MLA_SCALE = (MLA_NOPE_DIM + MLA_ROPE_DIM) ** -0.5

HG_HEADS = 8
HG_DK = D_MODEL // HG_HEADS
HG_DV = D_MODEL // HG_HEADS
HG_CHUNK = 32

SWA_HEADS = 16
SWA_KV_HEADS = 4
SWA_GROUP = SWA_HEADS // SWA_KV_HEADS
SWA_HEAD_DIM = 64
SWA_WINDOW = 128
SWA_BLOCK = 128
SWA_SCALE = SWA_HEAD_DIM ** -0.5

D_FF = -(-8 * D_MODEL // (3 * 256)) * 256
Q_BLOCK = 128
ROPE_BASE = 10000.0
NORM_EPS = 1e-6
NEG_INF = -1e30

kernel_name = 'hybrid_dit_mla_hgrn2_swa_step'

F32 = jnp.float32


def _rmsnorm(x, g):
    xf = x.astype(F32)
    y = xf * lax.rsqrt(jnp.mean(xf * xf, axis=-1, keepdims=True) + NORM_EPS)
    return (y * g.astype(F32)).astype(x.dtype)


def _adaln(cond, w, b):
    m = jax.nn.silu(cond) @ w + b
    return [t[:, None, :] for t in jnp.split(m, 6, axis=-1)]


def _modulate(x, g, shift, scale):
    return _rmsnorm(x, g) * (1.0 + scale) + shift


def _axial_rope(x):
    S, R = x.shape[1], x.shape[-1]
    rows = S // GRID_W
    row = jnp.repeat(jnp.arange(rows), GRID_W).astype(F32)
    col = jnp.tile(jnp.arange(GRID_W), rows).astype(F32)
    n_freq = R // 4
    inv_freq = ROPE_BASE ** (-jnp.arange(n_freq, dtype=F32) / n_freq)
    bshape = (S,) + (1,) * (x.ndim - 3) + (n_freq,)

    def rot(xa, pos):
        ang = (pos[:, None] * inv_freq[None, :]).reshape(bshape)
        cos, sin = jnp.cos(ang), jnp.sin(ang)
        x1, x2 = xa[..., :n_freq].astype(F32), xa[..., n_freq:].astype(F32)
        return jnp.concatenate([x1 * cos - x2 * sin, x1 * sin + x2 * cos], axis=-1)

    half = R // 2
    out = jnp.concatenate([rot(x[..., :half], row), rot(x[..., half:], col)], axis=-1)
    return out.astype(x.dtype)


def _dense_attention(q, k, v, scale, sink=None):
    B, Sq, Hkv, G, Dk = q.shape
    nb = Sq // Q_BLOCK
    qb = jnp.moveaxis(q.reshape(B, nb, Q_BLOCK, Hkv, G, Dk), 1, 0)

    def block(qblk):
        s = jnp.einsum('bqhgd,bkhd->bhgqk', qblk, k).astype(F32) * scale
        if sink is not None:
            z = jnp.broadcast_to(sink.astype(F32)[None, :, :, None, None], s.shape[:-1] + (1,))
            p = jax.nn.softmax(jnp.concatenate([s, z], axis=-1), axis=-1)[..., :-1]
        else:
            p = jax.nn.softmax(s, axis=-1)
        return jnp.einsum('bhgqk,bkhd->bqhgd', p.astype(v.dtype), v)

    o = lax.map(block, qb)
    return jnp.moveaxis(o, 0, 1).reshape(B, Sq, Hkv, G, v.shape[-1])


def _band_attention_with_ctx(q, k, v, k_ctx, v_ctx, sink, scale):
    B, S, Hkv, G, D = q.shape
    nb = S // SWA_BLOCK
    qb = q.reshape(B, nb, SWA_BLOCK, Hkv, G, D)

    def band(t):
        tp = jnp.pad(t, ((0, 0), (SWA_BLOCK, SWA_BLOCK), (0, 0), (0, 0)))
        tp = tp.reshape(B, nb + 2, SWA_BLOCK, Hkv, D)
        return jnp.concatenate([tp[:, :-2], tp[:, 1:-1], tp[:, 2:]], axis=2)

    kb, vb = band(k), band(v)
    s_loc = jnp.einsum('bnqhgd,bnkhd->bnhgqk', qb, kb).astype(F32) * scale
    blk = jnp.arange(nb)[:, None, None]
    qpos = blk * SWA_BLOCK + jnp.arange(SWA_BLOCK)[None, :, None]
    kpos = (blk - 1) * SWA_BLOCK + jnp.arange(3 * SWA_BLOCK)[None, None, :]
    valid = (jnp.abs(qpos - kpos) <= SWA_WINDOW) & (kpos >= 0) & (kpos < S)
    s_loc = jnp.where(valid[None, :, None, None], s_loc, NEG_INF)
    s_ctx = jnp.einsum('bnqhgd,blhd->bnhgql', qb, k_ctx).astype(F32) * scale
    z = jnp.broadcast_to(sink.astype(F32)[None, None, :, :, None, None], s_ctx.shape[:-1] + (1,))
    p = jax.nn.softmax(jnp.concatenate([s_ctx, s_loc, z], axis=-1), axis=-1)
    L = k_ctx.shape[1]
    p_ctx = p[..., :L].astype(v.dtype)
    p_loc = p[..., L:L + 3 * SWA_BLOCK].astype(v.dtype)
    o = (jnp.einsum('bnhgql,blhd->bnqhgd', p_ctx, v_ctx)
         + jnp.einsum('bnhgqk,bnkhd->bnqhgd', p_loc, vb))
    return o.reshape(B, S, Hkv, G, D)


def _mla_q(xn, w_dq, q_norm, w_uq):
    B, S, _ = xn.shape
    q = (_rmsnorm(xn @ w_dq, q_norm) @ w_uq).reshape(B, S, MLA_HEADS, MLA_NOPE_DIM + MLA_ROPE_DIM)
    return q[..., :MLA_NOPE_DIM], q[..., MLA_NOPE_DIM:]


def _mla_compress(xn, w_dkv, kv_norm):
    kv = xn @ w_dkv
    return _rmsnorm(kv[..., :MLA_KV_LORA], kv_norm), kv[..., MLA_KV_LORA:]


def _mla_expand(c_kv, k_rope, w_uk, w_uv):
    B, S, _ = c_kv.shape
    k_nope = (c_kv @ w_uk).reshape(B, S, MLA_HEADS, MLA_NOPE_DIM)
    k_r = jnp.broadcast_to(k_rope[:, :, None, :], (B, S, MLA_HEADS, MLA_ROPE_DIM)).astype(k_nope.dtype)
    v = (c_kv @ w_uv).reshape(B, S, MLA_HEADS, MLA_V_DIM)
    return jnp.concatenate([k_nope, k_r], axis=-1), v


def _mla_context(xn, w_dq, q_norm, w_uq, w_dkv, kv_norm, w_uk, w_uv, w_o):
    B, S, _ = xn.shape
    q_nope, q_rope = _mla_q(xn, w_dq, q_norm, w_uq)
    c_kv, k_rope = _mla_compress(xn, w_dkv, kv_norm)
    k, v = _mla_expand(c_kv, k_rope, w_uk, w_uv)
    q = jnp.concatenate([q_nope, q_rope], axis=-1)[:, :, :, None, :]
    o = _dense_attention(q, k, v, MLA_SCALE)
    return o.reshape(B, S, MLA_HEADS * MLA_V_DIM) @ w_o, c_kv, k_rope


def _mla_latent(xn, ckv_ctx, krope_ctx, w_dq, q_norm, w_uq, w_dkv, kv_norm, w_uk, w_uv, w_o):
    B, S, _ = xn.shape
    q_nope, q_rope = _mla_q(xn, w_dq, q_norm, w_uq)
    q = jnp.concatenate([q_nope, _axial_rope(q_rope)], axis=-1)[:, :, :, None, :]
    c_kv, k_rope = _mla_compress(xn, w_dkv, kv_norm)
    k_lat, v_lat = _mla_expand(c_kv, _axial_rope(k_rope), w_uk, w_uv)
    k_ctx, v_ctx = _mla_expand(ckv_ctx.astype(xn.dtype), krope_ctx.astype(xn.dtype), w_uk, w_uv)
    k = jnp.concatenate([k_ctx, k_lat], axis=1)
    v = jnp.concatenate([v_ctx, v_lat], axis=1)
    o = _dense_attention(q, k, v, MLA_SCALE)
    return o.reshape(B, S, MLA_HEADS * MLA_V_DIM) @ w_o


def _hgrn_lower_bound(lb_logits, layer):
    s = jax.nn.softmax(lb_logits.astype(F32), axis=0)
    return jnp.cumsum(s, axis=0)[layer] - s[0]


def _gla_chunk_scan(q, k, v, logf, s0):
    B, H, S, K = q.shape
    V = v.shape[-1]
    n = S // HG_CHUNK

    def to_chunks(a):
        return a.reshape(B, H, n, HG_CHUNK, a.shape[-1]).transpose(2, 0, 1, 3, 4)

    tri = jnp.tril(jnp.ones((HG_CHUNK, HG_CHUNK), dtype=bool))

    def step(state, inp):
        qc, kc, vc, fc = inp
        b = jnp.cumsum(fc, axis=2)
        o_inter = jnp.einsum('bhtk,bhkv->bhtv', qc * jnp.exp(b), state)
        diff = b[:, :, :, None, :] - b[:, :, None, :, :]
        decay = jnp.exp(jnp.where(tri[None, None, :, :, None], diff, -jnp.inf))
        att = jnp.einsum('bhtk,bhsk,bhtsk->bhts', qc, kc, decay)
        o = o_inter + jnp.einsum('bhts,bhsv->bhtv', att, vc)
        b_last = b[:, :, -1:, :]
        k_dec = kc * jnp.exp(b_last - b)
        new_state = jnp.exp(b_last[:, :, 0, :])[..., None] * state + jnp.einsum('bhsk,bhsv->bhkv', k_dec, vc)
        return new_state, o

    s_fin, o = lax.scan(step, s0.astype(F32), (to_chunks(q), to_chunks(k), to_chunks(v), to_chunks(logf)))
    return o.transpose(1, 2, 0, 3, 4).reshape(B, H, S, V), s_fin


def _hgrn_mix(xn, s0_fwd, s0_bwd, lb_fwd, lb_bwd, w_q, w_f, w_i, w_g, o_norm, w_o):
    B, S, _ = xn.shape

    def heads(t, d):
        return t.reshape(B, S, HG_HEADS, d).transpose(0, 2, 1, 3).astype(F32)

    q = heads(jax.nn.silu(xn @ w_q), HG_DK)
    v = heads(xn @ w_i, HG_DV)
    f_fwd = lb_fwd + (1.0 - lb_fwd) * jax.nn.sigmoid((xn @ w_f[0]).astype(F32))
    f_bwd = lb_bwd + (1.0 - lb_bwd) * jax.nn.sigmoid((xn @ w_f[1]).astype(F32))
    flip = lambda t: jnp.flip(t, axis=2)
    o_f, s_f = _gla_chunk_scan(q, heads(1.0 - f_fwd, HG_DK), v, heads(jnp.log(f_fwd), HG_DK), s0_fwd)
    o_b, s_b = _gla_chunk_scan(flip(q), flip(heads(1.0 - f_bwd, HG_DK)), flip(v),
                               flip(heads(jnp.log(f_bwd), HG_DK)), s0_bwd)
    o = (o_f + flip(o_b)).transpose(0, 2, 1, 3)
    g = jax.nn.silu((xn @ w_g).reshape(B, S, HG_HEADS, HG_DV).astype(F32))
    o = (_rmsnorm(o, o_norm) * g).reshape(B, S, HG_HEADS * HG_DV).astype(xn.dtype)
    return o @ w_o, s_f, s_b


def _swa_qkv(xn, w_q, w_k, w_v):
    B, S, _ = xn.shape
    q = (xn @ w_q).reshape(B, S, SWA_KV_HEADS, SWA_GROUP, SWA_HEAD_DIM)
    k = (xn @ w_k).reshape(B, S, SWA_KV_HEADS, SWA_HEAD_DIM)
    v = (xn @ w_v).reshape(B, S, SWA_KV_HEADS, SWA_HEAD_DIM)
    return q, k, v


def _swa_context(xn, sink, w_q, w_k, w_v, w_o):
    B, S, _ = xn.shape
    q, k, v = _swa_qkv(xn, w_q, w_k, w_v)
    o = _dense_attention(q, k, v, SWA_SCALE, sink)
    return o.reshape(B, S, SWA_HEADS * SWA_HEAD_DIM) @ w_o, k, v


def _swa_latent(xn, k_ctx, v_ctx, sink, w_q, w_k, w_v, w_o):
    B, S, _ = xn.shape
    q, k, v = _swa_qkv(xn, w_q, w_k, w_v)
    o = _band_attention_with_ctx(_axial_rope(q), _axial_rope(k), v, k_ctx.astype(xn.dtype),
                                 v_ctx.astype(xn.dtype), sink, SWA_SCALE)
    return o.reshape(B, S, SWA_HEADS * SWA_HEAD_DIM) @ w_o


def _swiglu(h, w_gate, w_up, w_down):
    return (jax.nn.silu(h @ w_gate) * (h @ w_up)) @ w_down


def setup_inputs(seed: int = 0) -> dict:
    key = jax.random.key(seed)
    ks = iter(jax.random.split(key, 64))
    D = D_MODEL

    def nrm(shape, scale=1.0):
        return jax.random.normal(next(ks), shape, F32) * scale

    def w(shape, fan_in, scale=1.0):
        return nrm(shape, scale * fan_in ** -0.5)

    def gain(shape):
        return 1.0 + nrm(shape, 0.02)

    return {
        'x_prompt': nrm((BATCH, SEQ, D)),
        'x_sample': nrm((DEC_BATCH, DEC_SEQ, D)),
        'cache_mla_ckv': nrm((DEC_BATCH, N_MLA, PAST_LEN, MLA_KV_LORA)),
        'cache_mla_krope': nrm((DEC_BATCH, N_MLA, PAST_LEN, MLA_ROPE_DIM)),
        'state_hgrn': nrm((DEC_BATCH, N_HGRN, 2, HG_HEADS, HG_DK, HG_DV), 0.5),
        'cache_swa_k': nrm((DEC_BATCH, N_SWA, PAST_LEN, SWA_KV_HEADS, SWA_HEAD_DIM)),
        'cache_swa_v': nrm((DEC_BATCH, N_SWA, PAST_LEN, SWA_KV_HEADS, SWA_HEAD_DIM)),
        'c': nrm((DEC_BATCH, D)),
        'c_ctx': nrm((D,)),
        'ada_w': w((DEPTH, D, 6 * D), D, 0.5),
        'ada_b': nrm((DEPTH, 6 * D), 0.02),
        'norm_mix': gain((DEPTH, D)),
        'norm_ffn': gain((DEPTH, D)),
        'ffn_w_gate': w((DEPTH, D, D_FF), D),
        'ffn_w_up': w((DEPTH, D, D_FF), D),
        'ffn_w_down': w((DEPTH, D_FF, D), D_FF),
        'final_norm': gain((D,)),
        'mla_w_dq': w((N_MLA, D, MLA_Q_LORA), D),
        'mla_q_norm': gain((N_MLA, MLA_Q_LORA)),
        'mla_w_uq': w((N_MLA, MLA_Q_LORA, MLA_HEADS * (MLA_NOPE_DIM + MLA_ROPE_DIM)), MLA_Q_LORA),
        'mla_w_dkv': w((N_MLA, D, MLA_KV_LORA + MLA_ROPE_DIM), D),
        'mla_kv_norm': gain((N_MLA, MLA_KV_LORA)),
        'mla_w_uk': w((N_MLA, MLA_KV_LORA, MLA_HEADS * MLA_NOPE_DIM), MLA_KV_LORA),
        'mla_w_uv': w((N_MLA, MLA_KV_LORA, MLA_HEADS * MLA_V_DIM), MLA_KV_LORA),
        'mla_w_o': w((N_MLA, MLA_HEADS * MLA_V_DIM, D), MLA_HEADS * MLA_V_DIM),
        'hg_w_q': w((N_HGRN, D, HG_HEADS * HG_DK), D),
        'hg_w_f': w((N_HGRN, 2, D, HG_HEADS * HG_DK), D),
        'hg_w_i': w((N_HGRN, D, HG_HEADS * HG_DV), D),
        'hg_w_g': w((N_HGRN, D, HG_HEADS * HG_DV), D),
        'hg_o_norm': gain((N_HGRN, HG_DV)),
        'hg_w_o': w((N_HGRN, HG_HEADS * HG_DV, D), HG_HEADS * HG_DV),
        'hg_lb_logits': nrm((2, DEPTH, HG_HEADS * HG_DK), 0.5),
        'swa_w_q': w((N_SWA, D, SWA_HEADS * SWA_HEAD_DIM), D),
        'swa_w_k': w((N_SWA, D, SWA_KV_HEADS * SWA_HEAD_DIM), D),
        'swa_w_v': w((N_SWA, D, SWA_KV_HEADS * SWA_HEAD_DIM), D),
        'swa_w_o': w((N_SWA, SWA_HEADS * SWA_HEAD_DIM, D), SWA_HEADS * SWA_HEAD_DIM),
        'swa_sink': nrm((N_SWA, SWA_HEADS), 0.5),
    }


def reference(x_prompt, x_sample, cache_mla_ckv, cache_mla_krope, state_hgrn, cache_swa_k, cache_swa_v,
              c, c_ctx, ada_w, ada_b, norm_mix, norm_ffn, ffn_w_gate, ffn_w_up, ffn_w_down, final_norm,
              mla_w_dq, mla_q_norm, mla_w_uq, mla_w_dkv, mla_kv_norm, mla_w_uk, mla_w_uv, mla_w_o,
              hg_w_q, hg_w_f, hg_w_i, hg_w_g, hg_o_norm, hg_w_o, hg_lb_logits,
              swa_w_q, swa_w_k, swa_w_v, swa_w_o, swa_sink):
    x_p, x_s = x_prompt, x_sample
    n_prompt = x_p.shape[0]
    new_ckv, new_krope, new_hg, new_k, new_v = [], [], [], [], []
    for i in range(DEPTH):
        kind, j = i % N_MIXERS, i // N_MIXERS
        sh1p, sc1p, g1p, sh2p, sc2p, g2p = _adaln(c_ctx[None, :], ada_w[i], ada_b[i])
        sh1s, sc1s, g1s, sh2s, sc2s, g2s = _adaln(c, ada_w[i], ada_b[i])
        hp = _modulate(x_p, norm_mix[i], sh1p, sc1p)
        hs = _modulate(x_s, norm_mix[i], sh1s, sc1s)
        if kind == 0:
            p = (mla_w_dq[j], mla_q_norm[j], mla_w_uq[j], mla_w_dkv[j], mla_kv_norm[j],
                 mla_w_uk[j], mla_w_uv[j], mla_w_o[j])
            yp, ckv, krope = _mla_context(hp, *p)
            ys = _mla_latent(hs, cache_mla_ckv[:, j], cache_mla_krope[:, j], *p)
            new_ckv.append(ckv)
            new_krope.append(krope)
        elif kind == 1:
            lb_f = _hgrn_lower_bound(hg_lb_logits[0], i)
            lb_b = _hgrn_lower_bound(hg_lb_logits[1], i)
            p = (hg_w_q[j], hg_w_f[j], hg_w_i[j], hg_w_g[j], hg_o_norm[j], hg_w_o[j])
            zeros = jnp.zeros((n_prompt, HG_HEADS, HG_DK, HG_DV), F32)
            yp, s_f, s_b = _hgrn_mix(hp, zeros, zeros, lb_f, lb_b, *p)
            ys, _, _ = _hgrn_mix(hs, state_hgrn[:, j, 0], state_hgrn[:, j, 1], lb_f, lb_b, *p)
            new_hg.append(jnp.stack([s_f, s_b], axis=1))
        else:
            sink = swa_sink[j].reshape(SWA_KV_HEADS, SWA_GROUP)
            p = (swa_w_q[j], swa_w_k[j], swa_w_v[j], swa_w_o[j])
            yp, k_c, v_c = _swa_context(hp, sink, *p)
            ys = _swa_latent(hs, cache_swa_k[:, j], cache_swa_v[:, j], sink, *p)
            new_k.append(k_c)
            new_v.append(v_c)
        x_p = x_p + g1p * yp
        x_s = x_s + g1s * ys
        x_p = x_p + g2p * _swiglu(_modulate(x_p, norm_ffn[i], sh2p, sc2p), ffn_w_gate[i], ffn_w_up[i], ffn_w_down[i])
        x_s = x_s + g2s * _swiglu(_modulate(x_s, norm_ffn[i], sh2s, sc2s), ffn_w_gate[i], ffn_w_up[i], ffn_w_down[i])
    y_prompt = _rmsnorm(x_p, final_norm)
    y_sample = _rmsnorm(x_s, final_norm)
    return (y_prompt, y_sample, jnp.stack(new_ckv, axis=1), jnp.stack(new_krope, axis=1),
            jnp.stack(new_hg, axis=1), jnp.stack(new_k, axis=1), jnp.stack(new_v, axis=1))
```

```cpp
#include <hip/hip_runtime.h>
#include <hip/hip_cooperative_groups.h>
#include <cstdio>
namespace cg = cooperative_groups;

typedef unsigned short u16;
typedef _Float16 f16;
using bf16x8 = __attribute__((ext_vector_type(8))) short;
using s16x4  = __attribute__((ext_vector_type(4))) short;
using f32x16 = __attribute__((ext_vector_type(16))) float;
using u32x4  = __attribute__((ext_vector_type(4))) unsigned;
using f32x4  = __attribute__((ext_vector_type(4))) float;
#define DI __device__ __forceinline__
#define MFMA32(a, b, c) __builtin_amdgcn_mfma_f32_32x32x16_bf16((a), (b), (c), 0, 0, 0)

#define MP 8192
#define MS 4096
#define MT 12288
#define DM 1024
#define DFF 2816
#define KROWS 12800
#define LOG2E 1.4426950408889634f
#define SMEM_BYTES 147456

struct Params {
  const float* in[37];
  float* out;
  u16 *Wgu, *Wd, *Wdqkv, *Wuq, *Wukv, *Wmo, *Wh, *Who, *Wsqkv, *Wso;
  float *X, *mod, *lb;
  u16 *CKVk, *KRk, *KSk, *VtS2;
  char* arena;
  unsigned* bar;
};
typedef const __attribute__((address_space(4))) Params& CP;

#define OUT_YP 0
#define OUT_YS 8388608
#define OUT_CKV 12582912
#define OUT_KR 16777216
#define OUT_HG 17825792
#define OUT_SK 26214400
#define OUT_SV 28311552


#define HALF_LDS 73728
#define VTID ((int)(threadIdx.x & 255))
#define VHALF ((int)(threadIdx.x >> 8))
#define VBLK ((int)(blockIdx.x * 2 + (threadIdx.x >> 8)))
#define VGRID ((int)(gridDim.x * 2))
__shared__ unsigned g_hbar[2 * 32];
DI void hbar_impl() {
  asm volatile("s_waitcnt lgkmcnt(0)" ::: "memory");
  if ((threadIdx.x & 63) == 0) {
    unsigned* c = &g_hbar[(threadIdx.x >> 8) * 32];
    const unsigned old = __hip_atomic_fetch_add(c, 1u, __ATOMIC_RELAXED, __HIP_MEMORY_SCOPE_WORKGROUP);
    const unsigned target = (old / 4u + 1u) * 4u;
    while (__hip_atomic_load(c, __ATOMIC_RELAXED, __HIP_MEMORY_SCOPE_WORKGROUP) < target) __builtin_amdgcn_s_sleep(1);
  }
  asm volatile("" ::: "memory");
}
#define HBAR() hbar_impl()
__shared__ int g_tidtab[512];
DI int opq_full() { return ((volatile int*)g_tidtab)[threadIdx.x]; }
DI u16 f2bf(float x) { unsigned u = __float_as_uint(x); u += 0x7fffu + ((u >> 16) & 1u); return (u16)(u >> 16); }
DI float bf2f(u16 v) { return __uint_as_float(((unsigned)v) << 16); }
DI unsigned pack2(float a, float b) { return (unsigned)f2bf(a) | ((unsigned)f2bf(b) << 16); }
DI bf16x8 pack8(float a0, float a1, float a2, float a3, float a4, float a5, float a6, float a7) {
  u32x4 p; p[0] = pack2(a0, a1); p[1] = pack2(a2, a3); p[2] = pack2(a4, a5); p[3] = pack2(a6, a7);
  return __builtin_bit_cast(bf16x8, p);
}
DI float silu_f(float x) { return x * __builtin_amdgcn_rcpf(1.f + __expf(-x)); }
DI float sigmoid_f(float x) { return __builtin_amdgcn_rcpf(1.f + __expf(-x)); }
DI int crow(int i, int h) { return (i & 3) + 8 * (i >> 2) + 4 * h; }
DI int keyrow_of(int m) {
  if (m < MP) return m;
  int mm = m - MP; int b = mm >> 11; int s = mm & 2047;
  return MP + b * 2304 + 256 + s;
}
DI int grp_of(int m) { return m < MP ? 0 : 1 + ((m - MP) >> 11); }
DI float rope1(float v, float partner, int d64, int s) {
  int jj = d64 & 15;
  float pos = (float)((d64 & 32) ? (s & 63) : (s >> 6));
  float inv = __builtin_amdgcn_exp2f(-(float)jj * 0.83048202372184058696f);
  float ang = pos * inv;
  float sn = __sinf(ang), cs = __cosf(ang);
  return (d64 & 16) ? (partner * sn + v * cs) : (v * cs - partner * sn);
}


#define XB_TMO      128
#define XB_XCNT(j)  (256  + 64 * (j))
#define XB_XSUB(j)  (1280 + 64 * (j))
#define XB_XGEN(j)  (2304 + 64 * (j))
#define XB_TOP      3328
#define XB_TOPGEN   3392
#define XCD_BAR_WORDS 3456
#define XB_SPIN_CAP (1u << 18)
#define LAS __attribute__((address_space(3)))
DI unsigned xb_ld(unsigned* p)              { return __hip_atomic_load(p, __ATOMIC_RELAXED, __HIP_MEMORY_SCOPE_AGENT); }
DI unsigned xb_add(unsigned* p, unsigned v) { return __hip_atomic_fetch_add(p, v, __ATOMIC_RELAXED, __HIP_MEMORY_SCOPE_AGENT); }
DI unsigned xb_xcc_id() { return (unsigned)__builtin_amdgcn_s_getreg((3 << 11) | 20) & 0xFu; }
#define XB_SPIN(cond, bar) do { unsigned _sp = 0; while (cond) { __builtin_amdgcn_s_sleep(1); \
    if ((++_sp & 255u) == 0u) { if (xb_ld(&(bar)[XB_TMO])) break; if (_sp > XB_SPIN_CAP) { atomicAdd(&(bar)[XB_TMO], 1u); break; } } } } while (0)
struct XcdBarrier { unsigned* bar; unsigned x; volatile LAS unsigned* st; };
DI XcdBarrier xcd_barrier_post(unsigned* bar, volatile LAS unsigned* st) {
  XcdBarrier b; b.bar = bar; b.x = xb_xcc_id(); b.st = st;
  if (threadIdx.x == 0) (void)xb_add(&bar[XB_XCNT(b.x)], 1u);
  return b;
}
DI void xcd_barrier_complete(unsigned* bar, unsigned x, unsigned& nloc, unsigned& nx) {
  const unsigned G = gridDim.x * gridDim.y * gridDim.z;
  unsigned sum, cnt, mine, sp = 0u;
  for (;;) {
    sum = 0u; cnt = 0u; mine = 0u;
#pragma unroll
    for (unsigned j = 0; j < 16; ++j) { const unsigned c = xb_ld(&bar[XB_XCNT(j)]); sum += c; cnt += (c > 0u) ? 1u : 0u; mine = (j == x) ? c : mine; }
    if (sum == G) break;
    __builtin_amdgcn_s_sleep(1);
    if ((++sp & 255u) == 0u) { if (xb_ld(&bar[XB_TMO])) break; if (sp > XB_SPIN_CAP) { atomicAdd(&bar[XB_TMO], 1u); break; } }
  }
  nloc = mine > 0u ? mine : 1u; nx = cnt > 0u ? cnt : 1u;
}
DI void xcd_barrier(const XcdBarrier& b) {
  asm volatile("s_waitcnt vmcnt(0)" ::: "memory");
  __syncthreads();
  if (threadIdx.x == 0) {
    unsigned* bar = b.bar;
    __builtin_amdgcn_s_waitcnt(0);
    unsigned nloc = b.st[0], nx = b.st[1];
    if (nloc == 0u) { xcd_barrier_complete(bar, b.x, nloc, nx); b.st[0] = nloc; b.st[1] = nx; }
    const unsigned old = xb_add(&bar[XB_XSUB(b.x)], 1u);
    const unsigned gen = old / nloc;
    if (old + 1u == (gen + 1u) * nloc) {
      __builtin_amdgcn_fence(__ATOMIC_RELEASE, "agent");
      asm volatile("s_waitcnt vmcnt(0)" ::: "memory");
      const unsigned og = xb_add(&bar[XB_TOP], 1u);
      const unsigned tg = og / nx;
      if (og + 1u == (tg + 1u) * nx) xb_add(&bar[XB_TOPGEN], 1u);
      else XB_SPIN(xb_ld(&bar[XB_TOPGEN]) == tg, bar);
      __builtin_amdgcn_fence(__ATOMIC_ACQUIRE, "agent");
      xb_add(&bar[XB_XGEN(b.x)], 1u);
      asm volatile("s_waitcnt vmcnt(0)" ::: "memory");
    } else {
      XB_SPIN(xb_ld(&bar[XB_XGEN(b.x)]) == gen, bar);
      __builtin_amdgcn_fence(__ATOMIC_ACQUIRE, "agent");
      asm volatile("s_waitcnt vmcnt(0)" ::: "memory");
    }
  }
  __syncthreads();
}

#define RAW_BARRIER() do { asm volatile("s_waitcnt lgkmcnt(0)" ::: "memory"); __builtin_amdgcn_s_barrier(); asm volatile("" ::: "memory"); } while (0)
template <int NJ, class Epi>
DI void gemm_tile(const u16* __restrict__ A, int lda, const u16* __restrict__ B, int ldb, int K, int m0, int n0, char* smem, Epi&& epi) {
  constexpr int BN = 64 * NJ;
  constexpr int NBI = BN / 128;
  constexpr int SA_BYTES = 256 * 64, SB_BYTES = BN * 64, STAGE = SA_BYTES + SB_BYTES;
  constexpr int NLD = 2 + NBI;
  static_assert(NLD == 4 || NLD == 3, "vmcnt immediates below assume this");
  const int tid = opq_full(), lane = tid & 63, w = tid >> 6, r = lane & 31, h = lane >> 5;
  const int wm = w >> 1, wn = w & 1;
  f32x16 acc[2][NJ];
#pragma unroll
  for (int i = 0; i < 2; ++i)
#pragma unroll
    for (int j = 0; j < NJ; ++j)
#pragma unroll
      for (int e = 0; e < 16; ++e) acc[i][j][e] = 0.f;
  const int drow = lane >> 2, dch = (lane & 3) ^ (lane >> 4);
  const u16* ga0 = A + (size_t)(m0 + (w * 2 + 0) * 16 + drow) * lda + dch * 8;
  const u16* ga1 = A + (size_t)(m0 + (w * 2 + 1) * 16 + drow) * lda + dch * 8;
  const u16* gb0 = B + (size_t)(n0 + (w * NBI + 0) * 16 + drow) * ldb + dch * 8;
  const u16* gb1 = B + (size_t)(n0 + (w * NBI + (NBI - 1)) * 16 + drow) * ldb + dch * 8;
  const int nk = K >> 5;
  const int rot = (m0 >> 8) % nk;
  auto issue = [&](int j, int buf) {
    int jj = j < nk ? j : nk - 1;
    int kk = rot + jj; kk = kk >= nk ? kk - nk : kk;
    const int k0 = kk * 32;
    char* sb_ = smem + buf * STAGE;
    __builtin_amdgcn_global_load_lds((const unsigned*)(ga0 + k0), (__attribute__((address_space(3))) unsigned*)(sb_ + (w * 2 + 0) * 1024), 16, 0, 0);
    __builtin_amdgcn_global_load_lds((const unsigned*)(ga1 + k0), (__attribute__((address_space(3))) unsigned*)(sb_ + (w * 2 + 1) * 1024), 16, 0, 0);
    __builtin_amdgcn_global_load_lds((const unsigned*)(gb0 + k0), (__attribute__((address_space(3))) unsigned*)(sb_ + SA_BYTES + (w * NBI + 0) * 1024), 16, 0, 0);
    if (NBI == 2)
      __builtin_amdgcn_global_load_lds((const unsigned*)(gb1 + k0), (__attribute__((address_space(3))) unsigned*)(sb_ + SA_BYTES + (w * NBI + 1) * 1024), 16, 0, 0);
  };
  const unsigned sw = (unsigned)((r >> 2) & 3);
  const unsigned sbase = (unsigned)(size_t)smem;
  const unsigned so0 = ((0u * 2u + (unsigned)h) ^ sw) * 16u, so1 = ((1u * 2u + (unsigned)h) ^ sw) * 16u;
  const unsigned rowA = (unsigned)(wm * 64 + r) * 64u, rowB = (unsigned)SA_BYTES + (unsigned)(wn * 32 * NJ + r) * 64u;
#define LDS_RD(dst, addr, OFF) asm volatile("ds_read_b128 %0, %1 offset:%2" : "=v"(dst) : "v"(addr), "n"(OFF) : "memory")
  __syncthreads();
  issue(0, 0); issue(1, 1); issue(2, 2);
  for (int kt = 0; kt < nk; ++kt) {
    if (NLD == 4) asm volatile("s_waitcnt vmcnt(8)" ::: "memory"); else asm volatile("s_waitcnt vmcnt(6)" ::: "memory");
    RAW_BARRIER();
    issue(kt + 3, (kt + 3) & 3);
    const unsigned st = sbase + (unsigned)(kt & 3) * (unsigned)STAGE;
    const unsigned pa0 = st + rowA + so0, pa1 = st + rowA + so1, pb0 = st + rowB + so0, pb1 = st + rowB + so1;
    bf16x8 a00, a10, a01, a11, b0[NJ], b1[NJ];
    LDS_RD(a00, pa0, 0); LDS_RD(a10, pa0, 2048);
    LDS_RD(b0[0], pb0, 0); LDS_RD(b0[1], pb0, 2048);
    if (NJ == 4) { LDS_RD(b0[NJ - 2], pb0, 4096); LDS_RD(b0[NJ - 1], pb0, 6144); }
    LDS_RD(a01, pa1, 0); LDS_RD(a11, pa1, 2048);
    LDS_RD(b1[0], pb1, 0); LDS_RD(b1[1], pb1, 2048);
    if (NJ == 4) { LDS_RD(b1[NJ - 2], pb1, 4096); LDS_RD(b1[NJ - 1], pb1, 6144); }
    if (NJ == 4) asm volatile("s_waitcnt lgkmcnt(6)" : "+v"(a00), "+v"(a10), "+v"(b0[0]), "+v"(b0[1]), "+v"(b0[NJ - 2]), "+v"(b0[NJ - 1]) :: "memory");
    else asm volatile("s_waitcnt lgkmcnt(4)" : "+v"(a00), "+v"(a10), "+v"(b0[0]), "+v"(b0[1]) :: "memory");
#pragma unroll
    for (int j = 0; j < NJ; ++j) {
      acc[0][j] = MFMA32(a00, b0[j], acc[0][j]);
      acc[1][j] = MFMA32(a10, b0[j], acc[1][j]);
    }
    if (NJ == 4) asm volatile("s_waitcnt lgkmcnt(0)" : "+v"(a01), "+v"(a11), "+v"(b1[0]), "+v"(b1[1]), "+v"(b1[NJ - 2]), "+v"(b1[NJ - 1]) :: "memory");
    else asm volatile("s_waitcnt lgkmcnt(0)" : "+v"(a01), "+v"(a11), "+v"(b1[0]), "+v"(b1[1]) :: "memory");
#pragma unroll
    for (int j = 0; j < NJ; ++j) {
      acc[0][j] = MFMA32(a01, b1[j], acc[0][j]);
      acc[1][j] = MFMA32(a11, b1[j], acc[1][j]);
    }
  }
  asm volatile("s_waitcnt vmcnt(0)" ::: "memory");
#pragma unroll
  for (int i = 0; i < 2; ++i)
#pragma unroll
    for (int g = 0; g < 4; ++g) {
      int m = m0 + wm * 64 + i * 32 + 8 * g + 4 * h;
#pragma unroll
      for (int jp = 0; jp < NJ / 2; ++jp) {
        float4 vA = make_float4(acc[i][2 * jp][4 * g], acc[i][2 * jp][4 * g + 1], acc[i][2 * jp][4 * g + 2], acc[i][2 * jp][4 * g + 3]);
        float4 vB = make_float4(acc[i][2 * jp + 1][4 * g], acc[i][2 * jp + 1][4 * g + 1], acc[i][2 * jp + 1][4 * g + 2], acc[i][2 * jp + 1][4 * g + 3]);
        epi(m, n0 + wn * 32 * NJ + jp * 64 + r, vA, vB);
      }
    }
}

DI float f4get(const float4& v, int e) { return e == 0 ? v.x : e == 1 ? v.y : e == 2 ? v.z : v.w; }

struct ConvP { const float* src; u16* dst; int N, ldd, row0, mode, k0, n0; };
DI ConvP conv_params(CP P, int t) {
  const float* src = nullptr; u16* dst = nullptr; int K = 0, N = 64, ldd = 0, row0 = 0, mode = 0; bool found = false;
#define TRY(SRC, KK, NN, DST, LDD, ROW0, MODE)                                   \
  if (!found) { int nt_ = ((KK) / 64) * ((NN) / 64);                              \
    if (t < nt_) { src = (SRC); K = (KK); N = (NN); dst = (DST); ldd = (LDD); row0 = (ROW0); mode = (MODE); found = true; } else t -= nt_; }
#pragma unroll
  for (int i = 0; i < 4; ++i) {
    TRY(P.in[13] + (size_t)i * DM * DFF, DM, DFF, P.Wgu + (size_t)i * 5632 * DM, DM, 0, 1)
    TRY(P.in[14] + (size_t)i * DM * DFF, DM, DFF, P.Wgu + (size_t)i * 5632 * DM, DM, 0, 2)
    TRY(P.in[15] + (size_t)i * DFF * DM, DFF, DM, P.Wd + (size_t)i * DM * DFF, DFF, 0, 0)
  }
#pragma unroll
  for (int j = 0; j < 2; ++j) {
    TRY(P.in[17] + (size_t)j * DM * 512, DM, 512, P.Wdqkv + (size_t)j * 1024 * DM, DM, 0, 0)
    TRY(P.in[20] + (size_t)j * DM * 320, DM, 320, P.Wdqkv + (size_t)j * 1024 * DM, DM, 512, 0)
    TRY(P.in[19] + (size_t)j * 512 * 1536, 512, 1536, P.Wuq + (size_t)j * 1536 * 512, 512, 0, 0)
    TRY(P.in[22] + (size_t)j * 256 * 1024, 256, 1024, P.Wukv + (size_t)j * 2048 * 256, 256, 0, 0)
    TRY(P.in[23] + (size_t)j * 256 * 1024, 256, 1024, P.Wukv + (size_t)j * 2048 * 256, 256, 1024, 0)
    TRY(P.in[24] + (size_t)j * DM * DM, DM, DM, P.Wmo + (size_t)j * DM * DM, DM, 0, 0)
  }
  TRY(P.in[25], DM, DM, P.Wh, DM, 0, 0)
  TRY(P.in[26], DM, DM, P.Wh, DM, 1024, 0)
  TRY(P.in[26] + (size_t)DM * DM, DM, DM, P.Wh, DM, 2048, 0)
  TRY(P.in[27], DM, DM, P.Wh, DM, 3072, 0)
  TRY(P.in[28], DM, DM, P.Wh, DM, 4096, 0)
  TRY(P.in[30], DM, DM, P.Who, DM, 0, 0)
  TRY(P.in[32], DM, DM, P.Wsqkv, DM, 0, 0)
  TRY(P.in[33], DM, 256, P.Wsqkv, DM, 1024, 0)
  TRY(P.in[34], DM, 256, P.Wsqkv, DM, 1280, 0)
  TRY(P.in[35], DM, DM, P.Wso, DM, 0, 0)
#undef TRY
  const int ntn = N / 64;
  const int tk = t / ntn, tn = t - tk * ntn;
  ConvP c; c.src = src; c.dst = dst; c.N = N; c.ldd = ldd; c.row0 = row0; c.mode = mode; c.k0 = tk * 64; c.n0 = tn * 64;
  return c;
}
#define CONV_LOAD(c, v0, v1, v2, v3, tid) do {                                                                         \
    const float* sp_ = (c).src + (size_t)((c).k0 + ((tid) >> 4)) * (c).N + (c).n0 + ((tid) & 15) * 4;                   \
    v0 = *(const f32x4*)(sp_); v1 = *(const f32x4*)(sp_ + (size_t)16 * (c).N);                                          \
    v2 = *(const f32x4*)(sp_ + (size_t)32 * (c).N); v3 = *(const f32x4*)(sp_ + (size_t)48 * (c).N); } while (0)
DI void conv_store(const ConvP& c, f32x4 v0, f32x4 v1, f32x4 v2, f32x4 v3, int tid, char* smem) {
  u16* t = (u16*)smem;
  HBAR();
  const int k = tid >> 4, n4 = (tid & 15) * 4;
#pragma unroll
  for (int j = 0; j < 4; ++j) {
    t[(n4 + j) * 72 + k] = f2bf(v0[j]);
    t[(n4 + j) * 72 + k + 16] = f2bf(v1[j]);
    t[(n4 + j) * 72 + k + 32] = f2bf(v2[j]);
    t[(n4 + j) * 72 + k + 48] = f2bf(v3[j]);
  }
  HBAR();
  const int n = tid >> 2, q = tid & 3;
  const int nn = c.n0 + n;
  const int row = c.mode == 0 ? c.row0 + nn : ((nn >> 5) * 64 + (c.mode == 2 ? 32 : 0) + (nn & 31));
  uint4 a = *(const uint4*)(t + n * 72 + q * 16);
  uint4 b = *(const uint4*)(t + n * 72 + q * 16 + 8);
  u16* d = c.dst + (size_t)row * c.ldd + c.k0 + q * 16;
  *(uint4*)d = a;
  *(uint4*)(d + 8) = b;
}
#define N_CONV_TILES 12192

DI void adaln_item(CP P, int it, char* smem) {
  const int i = it / 96, cb = it - i * 96;
  float* s = (float*)smem;
  const int tid = (opq_full() & 255);
  HBAR();
  for (int e = tid; e < 3072; e += 256) {
    int rr = e >> 10, k = e & 1023;
    float c = rr == 0 ? P.in[8][k] : P.in[7][(rr - 1) * 1024 + k];
    s[e] = silu_f(c);
  }
  HBAR();
  const int kg = tid >> 4, c4 = (tid & 15) * 4;
  const float* wp = P.in[9] + ((size_t)i * 1024 + kg * 64) * 6144 + cb * 64 + c4;
  f32x4 a0 = {0.f, 0.f, 0.f, 0.f}, a1 = a0, a2 = a0;
#pragma unroll 16
  for (int k = 0; k < 64; ++k) {
    f32x4 wv = *(const f32x4*)(wp + (size_t)k * 6144);
    a0 += s[kg * 64 + k] * wv;
    a1 += s[1024 + kg * 64 + k] * wv;
    a2 += s[2048 + kg * 64 + k] * wv;
  }
  float* red = s + 3072;
  *(f32x4*)(red + (kg * 3 + 0) * 64 + c4) = a0;
  *(f32x4*)(red + (kg * 3 + 1) * 64 + c4) = a1;
  *(f32x4*)(red + (kg * 3 + 2) * 64 + c4) = a2;
  HBAR();
  if (tid < 192) {
    const int rr = tid >> 6, c2 = tid & 63;
    float sum = 0.f;
#pragma unroll
    for (int g = 0; g < 16; ++g) sum += red[(g * 3 + rr) * 64 + c2];
    const int nn = cb * 64 + c2;
    P.mod[(size_t)(i * 3 + rr) * 6144 + nn] = sum + P.in[10][i * 6144 + nn];
  }
}

DI void misc_item(CP P, int it) {
  const int tid = (opq_full() & 255);
  for (int p = 0; p < 8; ++p) {
    int e = it * 2048 + p * 256 + tid;
    if (e < 262144) {
      int c = e & 255, l = (e >> 8) & 255, j = (e >> 16) & 1, b = e >> 17;
      P.CKVk[((size_t)j * KROWS + MP + b * 2304 + l) * 256 + c] = f2bf(P.in[2][e]);
    } else if (e < 262144 + 65536) {
      int e2 = e - 262144;
      int c = e2 & 63, l = (e2 >> 6) & 255, j = (e2 >> 14) & 1, b = e2 >> 15;
      P.KRk[((size_t)j * KROWS + MP + b * 2304 + l) * 64 + c] = f2bf(P.in[3][e2]);
    } else if (e < 262144 + 65536 + 131072) {
      int e2 = e - 327680;
      int c = e2 & 255, l = (e2 >> 8) & 255, b = e2 >> 16;
      P.KSk[((size_t)MP + b * 2304 + l) * 256 + c] = f2bf(P.in[5][e2]);
    } else if (e < 589824) {
      int e2 = e - 458752;
      int d = e2 & 63, kvh = (e2 >> 6) & 3, l = (e2 >> 8) & 255, b = e2 >> 16;
      P.VtS2[((size_t)(b * 4 + kvh) * 64 + d) * 2304 + l] = f2bf(P.in[6][e2]);
    }
  }
}
#define N_MISC_ITEMS 288

DI void phase0(CP P, char* smem) {
  const int tid = (opq_full() & 255);
  const int vb = VBLK, vg = VGRID;
  {
    int t = vb;
    ConvP cur; f32x4 v0, v1, v2, v3;
    if (t < N_CONV_TILES) { cur = conv_params(P, t); CONV_LOAD(cur, v0, v1, v2, v3, tid); }
    for (; t < N_CONV_TILES; t += vg) {
      const int tn = t + vg;
      ConvP nx = cur; f32x4 w0 = v0, w1 = v1, w2 = v2, w3 = v3;
      if (tn < N_CONV_TILES) { nx = conv_params(P, tn); CONV_LOAD(nx, w0, w1, w2, w3, tid); }
      conv_store(cur, v0, v1, v2, v3, tid, smem);
      cur = nx; v0 = w0; v1 = w1; v2 = w2; v3 = w3;
    }
  }
  for (int it = vg - 1 - vb; it < 384; it += vg) adaln_item(P, it, smem);
  for (int it = vb; it < N_MISC_ITEMS + 2; it += vg) {
    if (it < N_MISC_ITEMS) { misc_item(P, it); continue; }
    if (it == N_MISC_ITEMS) {
      for (int e = tid; e < 2048; e += 256) {
        int d = e >> 10, kd = e & 1023;
        const float* lg = P.in[31] + (size_t)d * 4 * 1024 + kd;
        float l0 = lg[0], l1 = lg[1024], l2 = lg[2048], l3 = lg[3072];
        float mx = fmaxf(fmaxf(l0, l1), fmaxf(l2, l3));
        float e0 = __expf(l0 - mx), e1 = __expf(l1 - mx), e2 = __expf(l2 - mx), e3 = __expf(l3 - mx);
        P.lb[e] = e1 / (e0 + e1 + e2 + e3);
      }
    } else {
      for (int e = tid; e < 2 * 192 * 1024 / 8; e += 256) {
        int j = e / (192 * 128), rem = e - j * 192 * 128;
        *(uint4*)(P.Wdqkv + (size_t)j * 1024 * DM + (size_t)832 * DM + (size_t)rem * 8) = make_uint4(0, 0, 0, 0);
      }
    }
  }
}

DI float wave_sum(float v) {
#pragma unroll
  for (int o = 32; o >= 1; o >>= 1) v += __shfl_xor(v, o);
  return v;
}

DI void normmod_phase(CP P, int layer, int which  , const float* gain, u16* H, bool first = false) {
  const int tid_ = (opq_full() & 255); const int lane = tid_ & 63, w = tid_ >> 6;
  const int stride = VGRID * 4;
  int m = VBLK * 4 + w;
  f32x4 g[4], v[4];
#pragma unroll
  for (int i = 0; i < 4; ++i) g[i] = *(const f32x4*)(gain + (i * 64 + lane) * 4);
  if (m < MT) {
    const float* x = first ? (m < MP ? P.in[0] + (size_t)m * DM : P.in[1] + (size_t)(m - MP) * DM) : P.X + (size_t)m * DM;
#pragma unroll
    for (int i = 0; i < 4; ++i) v[i] = *(const f32x4*)(x + (i * 64 + lane) * 4);
  }
  for (; m < MT; m += stride) {
    const int mn = m + stride;
    f32x4 nv[4];
#pragma unroll
    for (int i = 0; i < 4; ++i) nv[i] = v[i];
    if (mn < MT) {
      const float* xn = first ? (mn < MP ? P.in[0] + (size_t)mn * DM : P.in[1] + (size_t)(mn - MP) * DM) : P.X + (size_t)mn * DM;
#pragma unroll
      for (int i = 0; i < 4; ++i) nv[i] = *(const f32x4*)(xn + (i * 64 + lane) * 4);
    }
    const float* md = P.mod + (size_t)(layer * 3 + grp_of(m)) * 6144 + which * 3072;
    f32x4 sh[4], sc[4];
#pragma unroll
    for (int i = 0; i < 4; ++i) { sh[i] = *(const f32x4*)(md + (i * 64 + lane) * 4); sc[i] = *(const f32x4*)(md + 1024 + (i * 64 + lane) * 4); }
    float ss = 0.f;
#pragma unroll
    for (int i = 0; i < 4; ++i) ss += v[i].x * v[i].x + v[i].y * v[i].y + v[i].z * v[i].z + v[i].w * v[i].w;
    if (first) {
#pragma unroll
      for (int i = 0; i < 4; ++i) *(f32x4*)(P.X + (size_t)m * DM + (i * 64 + lane) * 4) = v[i];
    }
    ss = wave_sum(ss);
    const float rstd = rsqrtf(ss * (1.f / DM) + 1e-6f);
#pragma unroll
    for (int i = 0; i < 4; ++i) {
      const int c = (i * 64 + lane) * 4;
      f32x4 o = v[i] * rstd * g[i] * (1.f + sc[i]) + sh[i];
      *(uint2*)(H + (size_t)m * DM + c) = make_uint2(pack2(o.x, o.y), pack2(o.z, o.w));
    }
#pragma unroll
    for (int i = 0; i < 4; ++i) v[i] = nv[i];
  }
}

DI void final_norm_phase(CP P) {
  const int tid_ = (opq_full() & 255); const int lane = tid_ & 63, w = tid_ >> 6;
  for (int m = VBLK * 4 + w; m < MT; m += VGRID * 4) {
    const float* x = P.X + (size_t)m * DM;
    f32x4 v[4]; float ss = 0.f;
#pragma unroll
    for (int i = 0; i < 4; ++i) { v[i] = *(const f32x4*)(x + (i * 64 + lane) * 4); ss += v[i].x * v[i].x + v[i].y * v[i].y + v[i].z * v[i].z + v[i].w * v[i].w; }
    ss = wave_sum(ss);
    float rstd = rsqrtf(ss * (1.f / DM) + 1e-6f);
#pragma unroll
    for (int i = 0; i < 4; ++i) {
      int c = (i * 64 + lane) * 4;
      float4 g = *(const float4*)(P.in[16] + c);
      *(float4*)(P.out + (size_t)m * DM + c) = make_float4(v[i].x * rstd * g.x, v[i].y * rstd * g.y, v[i].z * rstd * g.z, v[i].w * rstd * g.w);
    }
  }
}

DI void mla_rownorm_phase(CP P, int j, const float* RAW, u16* QN) {
  const int tid_ = (opq_full() & 255); const int lane = tid_ & 63, w = tid_ >> 6;
  const float* qg = P.in[18] + j * 512;
  const float* kg = P.in[21] + j * 256;
  u16* CK = P.CKVk + (size_t)j * KROWS * 256;
  u16* KR = P.KRk + (size_t)j * KROWS * 64;
  for (int m = VBLK * 4 + w; m < MT; m += VGRID * 4) {
    const float* x = RAW + (size_t)m * 832;
    float4 q0 = *(const float4*)(x + lane * 4), q1 = *(const float4*)(x + 256 + lane * 4);
    float4 kv = *(const float4*)(x + 512 + lane * 4);
    float kr = x[768 + lane];
    float sq = q0.x * q0.x + q0.y * q0.y + q0.z * q0.z + q0.w * q0.w + q1.x * q1.x + q1.y * q1.y + q1.z * q1.z + q1.w * q1.w;
    float sk = kv.x * kv.x + kv.y * kv.y + kv.z * kv.z + kv.w * kv.w;
    sq = wave_sum(sq); sk = wave_sum(sk);
    float rq = rsqrtf(sq * (1.f / 512.f) + 1e-6f), rk = rsqrtf(sk * (1.f / 256.f) + 1e-6f);
    float4 g0 = *(const float4*)(qg + lane * 4), g1 = *(const float4*)(qg + 256 + lane * 4), g2 = *(const float4*)(kg + lane * 4);
    *(uint2*)(QN + (size_t)m * 512 + lane * 4) = make_uint2(pack2(q0.x * rq * g0.x, q0.y * rq * g0.y), pack2(q0.z * rq * g0.z, q0.w * rq * g0.w));
    *(uint2*)(QN + (size_t)m * 512 + 256 + lane * 4) = make_uint2(pack2(q1.x * rq * g1.x, q1.y * rq * g1.y), pack2(q1.z * rq * g1.z, q1.w * rq * g1.w));
    float4 c = make_float4(kv.x * rk * g2.x, kv.y * rk * g2.y, kv.z * rk * g2.z, kv.w * rk * g2.w);
    const int kr_row = keyrow_of(m);
    *(uint2*)(CK + (size_t)kr_row * 256 + lane * 4) = make_uint2(pack2(c.x, c.y), pack2(c.z, c.w));
    float partner = __shfl_xor(kr, 16);
    if (m < MP) {
      int b = m >> 8, s = m & 255;
      *(float4*)(P.out + OUT_CKV + ((size_t)(b * 2 + j) * 256 + s) * 256 + lane * 4) = c;
      P.out[OUT_KR + ((size_t)(b * 2 + j) * 256 + s) * 64 + lane] = kr;
      KR[(size_t)kr_row * 64 + lane] = f2bf(kr);
    } else {
      int s = (m - MP) & 2047;
      KR[(size_t)kr_row * 64 + lane] = f2bf(rope1(kr, partner, lane, s));
    }
  }
}

DI void hgrn_post_phase(CP P, const u16* Of, const u16* Ob, const u16* Gh, u16* A2) {
  const int tid_ = (opq_full() & 255); const int lane = tid_ & 63, w = tid_ >> 6;
  for (int m = VBLK * 4 + w; m < MT; m += VGRID * 4) {
#pragma unroll
    for (int i = 0; i < 4; ++i) {
      int c = (i * 64 + lane) * 4;
      uint2 a = *(const uint2*)(Of + (size_t)m * DM + c), b = *(const uint2*)(Ob + (size_t)m * DM + c), g = *(const uint2*)(Gh + (size_t)m * DM + c);
      float o0 = bf2f((u16)(a.x & 0xffff)) + bf2f((u16)(b.x & 0xffff));
      float o1 = bf2f((u16)(a.x >> 16)) + bf2f((u16)(b.x >> 16));
      float o2 = bf2f((u16)(a.y & 0xffff)) + bf2f((u16)(b.y & 0xffff));
      float o3 = bf2f((u16)(a.y >> 16)) + bf2f((u16)(b.y >> 16));
      float ss = o0 * o0 + o1 * o1 + o2 * o2 + o3 * o3;
#pragma unroll
      for (int o = 16; o >= 1; o >>= 1) ss += __shfl_xor(ss, o);
      float rstd = rsqrtf(ss * (1.f / 128.f) + 1e-6f);
      float4 gn = *(const float4*)(P.in[29] + (c & 127));
      o0 = o0 * rstd * gn.x * bf2f((u16)(g.x & 0xffff));
      o1 = o1 * rstd * gn.y * bf2f((u16)(g.x >> 16));
      o2 = o2 * rstd * gn.z * bf2f((u16)(g.y & 0xffff));
      o3 = o3 * rstd * gn.w * bf2f((u16)(g.y >> 16));
      *(uint2*)(A2 + (size_t)m * DM + c) = make_uint2(pack2(o0, o1), pack2(o2, o3));
    }
  }
}

template <int DKN, int DKR, int DV>
DI void attn_item(const u16* __restrict__ Q, int ldq, int qoff, int m0,
                  const u16* __restrict__ Kn, int ldk, int koff, const u16* __restrict__ Kr, int kbase,
                  const u16* __restrict__ Vt, int ldv,
                  int e1, int lo2, int hi2, bool win, int t0, float m_init, float l_init,
                  u16* __restrict__ O, int ldo, int ooff, char* smem, bool split = false) {
  constexpr int DK = DKN + DKR;
  constexpr int KST = DK * 2 + 16;
  constexpr int KBYTES = 32 * KST;
  constexpr int VBYTES = DV * 80;
  constexpr int STAGE = KBYTES + VBYTES;
  constexpr int KCH = DK / 8;
  constexpr int NKL = (32 * KCH) / 256;
  constexpr int NVL = (DV * 4) / 256;
  const int tfull = opq_full();
  const int tid = tfull & 255, vh = tfull >> 8, lane = tid & 63, w = tid >> 6, r = lane & 31, h = lane >> 5;

  bf16x8 qf[DK / 16];
  {
    const u16* qp = Q + (size_t)(m0 + w * 32 + r) * ldq + qoff + h * 8;
#pragma unroll
    for (int ks = 0; ks < DK / 16; ++ks) qf[ks] = *(const bf16x8*)(qp + ks * 16);
  }
  f32x16 o[DV / 32];
#pragma unroll
  for (int d = 0; d < DV / 32; ++d)
#pragma unroll
    for (int e = 0; e < 16; ++e) o[d][e] = 0.f;
  float mrun = m_init, lrun = (h == 0) ? l_init : 0.f;

  const int n1 = e1 >> 5;
  const int nsteps = n1 + ((hi2 - lo2) >> 5);
  const int sbeg = split ? vh * (nsteps >> 1) : 0;
  const int send = split ? sbeg + (nsteps >> 1) : nsteps;
  u32x4 rk[NKL], rv[NVL];
  auto gload = [&](int st) {
    const int kk = st < n1 ? st * 32 : lo2 + (st - n1) * 32;
#pragma unroll
    for (int i = 0; i < NKL; ++i) {
      int c = tid + 256 * i;
      int row = c / KCH, cc = c - row * KCH;
      size_t kr_ = (size_t)(kbase + kk + row);
      const u16* src = (cc < DKN / 8) ? (Kn + kr_ * ldk + koff + cc * 8) : (Kr + kr_ * 64 + (cc - DKN / 8) * 8);
      rk[i] = *(const u32x4*)src;
    }
#pragma unroll
    for (int i = 0; i < NVL; ++i) {
      int c = tid + 256 * i;
      int row = c >> 2, cc = c & 3;
      rv[i] = *(const u32x4*)(Vt + (size_t)row * ldv + kk + cc * 8);
    }
  };
  gload(sbeg);
  HBAR();
  for (int st = sbeg; st < send; ++st) {
    char* sk = smem + ((st - sbeg) & 1) * STAGE;
    char* sv = sk + KBYTES;
#pragma unroll
    for (int i = 0; i < NKL; ++i) {
      int c = tid + 256 * i;
      int row = c / KCH, cc = c - row * KCH;
      *(u32x4*)(sk + row * KST + cc * 16) = rk[i];
    }
#pragma unroll
    for (int i = 0; i < NVL; ++i) {
      int c = tid + 256 * i;
      int row = c >> 2, cc = c & 3;
      *(u32x4*)(sv + row * 80 + cc * 16) = rv[i];
    }
    HBAR();
    const int kk = st < n1 ? st * 32 : lo2 + (st - n1) * 32;
    if (st + 1 < send) gload(st + 1);
    f32x16 x;
#pragma unroll
    for (int e = 0; e < 16; ++e) x[e] = 0.f;
    const char* pk = sk + r * KST + h * 16;
#pragma unroll
    for (int ks = 0; ks < DK / 16; ++ks) {
      bf16x8 a = *(const bf16x8*)(pk + ks * 32);
      x = MFMA32(a, qf[ks], x);
    }
    if (win && kk >= 256) {
      const int t = t0 + w * 32 + r;
      const int sb = kk - 256;
#pragma unroll
      for (int e = 0; e < 16; ++e) {
        int dlt = t - (sb + crow(e, h));
        if (dlt > 128 || dlt < -128) x[e] = -1e30f;
      }
    }
    float mloc = x[0];
#pragma unroll
    for (int e = 1; e < 16; ++e) mloc = fmaxf(mloc, x[e]);
    mloc = fmaxf(mloc, __shfl_xor(mloc, 32));
    const float mnew = fmaxf(mrun, mloc);
    const float alpha = __builtin_amdgcn_exp2f(mrun - mnew);
    mrun = mnew;
    float psum = 0.f;
#pragma unroll
    for (int e = 0; e < 16; ++e) { x[e] = __builtin_amdgcn_exp2f(x[e] - mnew); psum += x[e]; }
    lrun = lrun * alpha + psum;
#pragma unroll
    for (int d = 0; d < DV / 32; ++d)
#pragma unroll
      for (int e = 0; e < 16; ++e) o[d][e] *= alpha;
    bf16x8 pb0 = pack8(x[0], x[1], x[2], x[3], x[4], x[5], x[6], x[7]);
    bf16x8 pb1 = pack8(x[8], x[9], x[10], x[11], x[12], x[13], x[14], x[15]);
#pragma unroll
    for (int d = 0; d < DV / 32; ++d) {
      const char* pv = sv + (d * 32 + r) * 80 + h * 8;
      s16x4 lo0 = *(const s16x4*)(pv), hi0 = *(const s16x4*)(pv + 16);
      s16x4 lo1 = *(const s16x4*)(pv + 32), hi1 = *(const s16x4*)(pv + 48);
      bf16x8 av0 = __builtin_shufflevector(lo0, hi0, 0, 1, 2, 3, 4, 5, 6, 7);
      bf16x8 av1 = __builtin_shufflevector(lo1, hi1, 0, 1, 2, 3, 4, 5, 6, 7);
      o[d] = MFMA32(av0, pb0, o[d]);
      o[d] = MFMA32(av1, pb1, o[d]);
    }
  }
  if (split) {
    float* xch = (float*)(vh ? smem : smem + HALF_LDS);
    HBAR();
    if (vh == 1) {
#pragma unroll
      for (int d = 0; d < DV / 32; ++d)
#pragma unroll
        for (int e = 0; e < 16; ++e) xch[(d * 16 + e) * 256 + tid] = o[d][e];
      xch[(DV / 2) * 256 + tid] = mrun;
      xch[(DV / 2 + 1) * 256 + tid] = lrun;
    }
    __syncthreads();
    if (vh == 0) {
      const float m1 = xch[(DV / 2) * 256 + tid], l1 = xch[(DV / 2 + 1) * 256 + tid];
      const float mnew = fmaxf(mrun, m1);
      const float a0 = __builtin_amdgcn_exp2f(mrun - mnew), a1 = __builtin_amdgcn_exp2f(m1 - mnew);
      lrun = lrun * a0 + l1 * a1;
#pragma unroll
      for (int d = 0; d < DV / 32; ++d)
#pragma unroll
        for (int e = 0; e < 16; ++e) o[d][e] = o[d][e] * a0 + xch[(d * 16 + e) * 256 + tid] * a1;
    }
    __syncthreads();
    if (vh == 1) return;
  }
  const float ltot = lrun + __shfl_xor(lrun, 32);
  const float inv = 1.f / ltot;
  u16* op = O + (size_t)(m0 + w * 32 + r) * ldo + ooff;
#pragma unroll
  for (int d = 0; d < DV / 32; ++d)
#pragma unroll
    for (int g = 0; g < 4; ++g)
      *(uint2*)(op + d * 32 + 8 * g + 4 * h) = make_uint2(pack2(o[d][4 * g] * inv, o[d][4 * g + 1] * inv), pack2(o[d][4 * g + 2] * inv, o[d][4 * g + 3] * inv));
}

DI void hgrn_item(CP P, int kind, int idx, const u16* Qh, const u16* Vh, const f16* LF, u16* Oout, float* Lbuf, float* Dbuf, char* smem) {
  const int tid = (opq_full() & 255), lane = tid & 63, w = tid >> 6, r = lane & 31, h = lane >> 5;
  int S, mb, hh, dir, bp = 0, bl = 0, seg = 0, q = 0;
  if (kind == 0) { bp = idx >> 4; hh = (idx >> 1) & 7; dir = idx & 1; S = 256; mb = bp * 256; }
  else {
    if (kind == 1) { q = idx / 7; seg = idx - q * 7; } else { q = idx >> 3; seg = idx & 7; }
    bl = q >> 4; hh = (q >> 1) & 7; dir = q & 1; S = 2048; mb = MP + bl * 2048;
  }
  const int u0 = seg * 256;
  const bool write_o = kind != 1;
  char* Qs = smem;
  char* Ks = smem + 8704;
  char* KsT = smem + 17408;
  char* VT = smem + 27648;
  float* erho = (float*)(smem + 37888);
  float* elast = erho + 128;
  float* exch = elast + 128;
  const f16* lf_base = LF + (size_t)dir * MT * DM;
  u16* Od = Oout + (size_t)dir * MT * DM;

  f32x16 st[4];
  if (kind != 2) {
#pragma unroll
    for (int t = 0; t < 4; ++t)
#pragma unroll
      for (int e = 0; e < 16; ++e) st[t][e] = 0.f;
  } else {
    const float* s0 = P.in[4] + ((size_t)((bl * 2 + dir) * 8 + hh)) * 128 * 128;
#pragma unroll
    for (int t = 0; t < 4; ++t)
#pragma unroll
      for (int e = 0; e < 16; ++e) st[t][e] = s0[(size_t)(32 * t + crow(e, h)) * 128 + 32 * w + r];
#pragma unroll 1
    for (int j = 0; j < seg; ++j) {
      const float* Lj = Lbuf + (size_t)(q * 7 + j) * 16384;
      const float* Dj = Dbuf + (size_t)(q * 7 + j) * 128;
#pragma unroll
      for (int t = 0; t < 4; ++t)
#pragma unroll
        for (int g = 0; g < 4; ++g) {
          int k = 32 * t + 8 * g + 4 * h;
          float4 dj = *(const float4*)(Dj + k);
          const float* lp = Lj + (size_t)k * 128 + 32 * w + r;
          st[t][4 * g] = dj.x * st[t][4 * g] + lp[0];
          st[t][4 * g + 1] = dj.y * st[t][4 * g + 1] + lp[128];
          st[t][4 * g + 2] = dj.z * st[t][4 * g + 2] + lp[256];
          st[t][4 * g + 3] = dj.w * st[t][4 * g + 3] + lp[384];
        }
    }
  }
  float dlog = 0.f;
  const int kd = tid & 127, th = tid >> 7;
  const int nch = 8;
  typedef _Float16 f16x2 __attribute__((ext_vector_type(2)));
  typedef unsigned short u16x2 __attribute__((ext_vector_type(2)));
  f16x2 plf[8]; u16x2 pq[8], pv[8];
#pragma unroll
  for (int t16 = 0; t16 < 16; ++t16) {
    int t = th * 16 + t16;
    int tok = dir ? (S - 1 - (u0 + t)) : (u0 + t);
    size_t gi = (size_t)(mb + tok) * DM + hh * 128 + kd;
    plf[t16 >> 1][t16 & 1] = lf_base[gi]; pq[t16 >> 1][t16 & 1] = Qh[gi]; pv[t16 >> 1][t16 & 1] = Vh[gi];
  }
  for (int c = 0; c < nch; ++c) {
    HBAR();
    float bc[16];
    float run = 0.f;
#pragma unroll
    for (int t16 = 0; t16 < 16; ++t16) {
      run += (float)plf[t16 >> 1][t16 & 1];
      bc[t16] = run;
    }
    if (th == 0) exch[kd] = run;
    HBAR();
    const float rho = exch[kd];
    if (th == 1) {
#pragma unroll
      for (int t16 = 0; t16 < 16; ++t16) bc[t16] += rho;
      elast[kd] = __expf(bc[15] - rho);
      erho[kd] = __expf(rho);
      dlog += bc[15];
    }
    unsigned kpk[8];
#pragma unroll
    for (int t16 = 0; t16 < 16; ++t16) {
      int t = th * 16 + t16;
      float q = bf2f(pq[t16 >> 1][t16 & 1]);
      float kval = 1.f - __expf((float)plf[t16 >> 1][t16 & 1]);
      float dq = bc[t16] - rho;
      u16 qb = f2bf(q * __expf(dq));
      u16 kb = f2bf(kval * __expf(-dq));
      *(u16*)(Qs + t * 272 + kd * 2) = qb;
      *(u16*)(Ks + t * 272 + kd * 2) = kb;
      if (t16 & 1) kpk[t16 >> 1] |= (unsigned)kb << 16; else kpk[t16 >> 1] = kb;
    }
#pragma unroll
    for (int i = 0; i < 4; ++i) {
      *(uint2*)(KsT + kd * 80 + (th * 16 + 4 * i) * 2) = make_uint2(kpk[2 * i], kpk[2 * i + 1]);
      *(uint2*)(VT + kd * 80 + (th * 16 + 4 * i) * 2) = make_uint2(__builtin_bit_cast(unsigned, pv[2 * i]), __builtin_bit_cast(unsigned, pv[2 * i + 1]));
    }
    if (c + 1 < nch) {
#pragma unroll
      for (int t16 = 0; t16 < 16; ++t16) {
        int t = th * 16 + t16;
        int tok = dir ? (S - 1 - (u0 + (c + 1) * 32 + t)) : (u0 + (c + 1) * 32 + t);
        size_t gi = (size_t)(mb + tok) * DM + hh * 128 + kd;
        plf[t16 >> 1][t16 & 1] = lf_base[gi]; pq[t16 >> 1][t16 & 1] = Qh[gi]; pv[t16 >> 1][t16 & 1] = Vh[gi];
      }
    }
    HBAR();
#pragma unroll
    for (int t = 0; t < 4; ++t)
#pragma unroll
      for (int g = 0; g < 4; ++g) {
        float4 er = *(const float4*)(erho + 32 * t + 8 * g + 4 * h);
        st[t][4 * g] *= er.x; st[t][4 * g + 1] *= er.y; st[t][4 * g + 2] *= er.z; st[t][4 * g + 3] *= er.w;
      }
    if (write_o) {
      f32x16 x;
#pragma unroll
      for (int e = 0; e < 16; ++e) x[e] = 0.f;
#pragma unroll
      for (int ks = 0; ks < 8; ++ks) {
        bf16x8 a = *(const bf16x8*)(Ks + r * 272 + ks * 32 + h * 16);
        bf16x8 b = *(const bf16x8*)(Qs + r * 272 + ks * 32 + h * 16);
        x = MFMA32(a, b, x);
      }
#pragma unroll
      for (int e = 0; e < 16; ++e) if (crow(e, h) > r) x[e] = 0.f;
      f32x16 oacc;
#pragma unroll
      for (int e = 0; e < 16; ++e) oacc[e] = 0.f;
#pragma unroll
      for (int t = 0; t < 4; ++t) {
        bf16x8 sb0 = pack8(st[t][0], st[t][1], st[t][2], st[t][3], st[t][4], st[t][5], st[t][6], st[t][7]);
        bf16x8 sb1 = pack8(st[t][8], st[t][9], st[t][10], st[t][11], st[t][12], st[t][13], st[t][14], st[t][15]);
        const char* pq = Qs + r * 272 + (32 * t + 4 * h) * 2;
        s16x4 lo0 = *(const s16x4*)(pq), hi0 = *(const s16x4*)(pq + 16);
        s16x4 lo1 = *(const s16x4*)(pq + 32), hi1 = *(const s16x4*)(pq + 48);
        bf16x8 qa0 = __builtin_shufflevector(lo0, hi0, 0, 1, 2, 3, 4, 5, 6, 7);
        bf16x8 qa1 = __builtin_shufflevector(lo1, hi1, 0, 1, 2, 3, 4, 5, 6, 7);
        oacc = MFMA32(qa0, sb0, oacc);
        oacc = MFMA32(qa1, sb1, oacc);
      }
      {
        bf16x8 xa0 = pack8(x[0], x[1], x[2], x[3], x[4], x[5], x[6], x[7]);
        bf16x8 xa1 = pack8(x[8], x[9], x[10], x[11], x[12], x[13], x[14], x[15]);
        const char* pv = VT + (32 * w + r) * 80 + h * 8;
        s16x4 lo0 = *(const s16x4*)(pv), hi0 = *(const s16x4*)(pv + 16);
        s16x4 lo1 = *(const s16x4*)(pv + 32), hi1 = *(const s16x4*)(pv + 48);
        bf16x8 vb0 = __builtin_shufflevector(lo0, hi0, 0, 1, 2, 3, 4, 5, 6, 7);
        bf16x8 vb1 = __builtin_shufflevector(lo1, hi1, 0, 1, 2, 3, 4, 5, 6, 7);
        oacc = MFMA32(xa0, vb0, oacc);
        oacc = MFMA32(xa1, vb1, oacc);
      }
#pragma unroll
      for (int e = 0; e < 16; ++e) {
        int t = crow(e, h);
        int tok = dir ? (S - 1 - (u0 + c * 32 + t)) : (u0 + c * 32 + t);
        Od[(size_t)(mb + tok) * DM + hh * 128 + 32 * w + r] = f2bf(oacc[e]);
      }
    }
    {
      const char* pv = VT + (32 * w + r) * 80 + h * 16;
      bf16x8 vn0 = *(const bf16x8*)(pv), vn1 = *(const bf16x8*)(pv + 32);
#pragma unroll
      for (int t = 0; t < 4; ++t) {
        const char* pk = KsT + (32 * t + r) * 80 + h * 16;
        bf16x8 ka0 = *(const bf16x8*)(pk), ka1 = *(const bf16x8*)(pk + 32);
        st[t] = MFMA32(ka0, vn0, st[t]);
        st[t] = MFMA32(ka1, vn1, st[t]);
#pragma unroll
        for (int g = 0; g < 4; ++g) {
          float4 el = *(const float4*)(elast + 32 * t + 8 * g + 4 * h);
          st[t][4 * g] *= el.x; st[t][4 * g + 1] *= el.y; st[t][4 * g + 2] *= el.z; st[t][4 * g + 3] *= el.w;
        }
      }
    }
  }
  if (kind == 0) {
    float* so = P.out + OUT_HG + ((size_t)((bp * 2 + dir) * 8 + hh)) * 128 * 128;
#pragma unroll
    for (int t = 0; t < 4; ++t)
#pragma unroll
      for (int e = 0; e < 16; ++e) so[(size_t)(32 * t + crow(e, h)) * 128 + 32 * w + r] = st[t][e];
  } else if (kind == 1) {
    float* so = Lbuf + (size_t)idx * 16384;
#pragma unroll
    for (int t = 0; t < 4; ++t)
#pragma unroll
      for (int e = 0; e < 16; ++e) so[(size_t)(32 * t + crow(e, h)) * 128 + 32 * w + r] = st[t][e];
    if (th == 1) Dbuf[(size_t)idx * 128 + kd] = __expf(dlog);
  }
}

DI void gemm_residual_phase(CP P, const u16* A, int K, const u16* Bt, int layer, int which  , char* smem) {
  const int tiles = (MT / 256) * (DM / 256);
  for (int t = blockIdx.x; t < tiles; t += gridDim.x) {
    int tm = t % (MT / 256), tn = t / (MT / 256);
    gemm_tile<4>(A, K, Bt, K, K, tm * 256, tn * 256, smem, [&](int m, int n, float4 vA, float4 vB) {
      const float* gate = P.mod + (size_t)(layer * 3 + grp_of(m)) * 6144 + which * 1024;
      float gA = gate[n], gB = gate[n + 32];
#pragma unroll
      for (int e = 0; e < 4; ++e) {
        float* xp = P.X + (size_t)(m + e) * DM + n;
        xp[0] += gA * f4get(vA, e);
        xp[32] += gB * f4get(vB, e);
      }
    });
  }
}

DI void ffn_block(CP P, const XcdBarrier& xb, int layer, char* smem) {
  u16* H = (u16*)P.arena;
  u16* ACT = (u16*)(P.arena + (size_t)24 * 1048576);
  normmod_phase(P, layer, 1, P.in[12] + layer * DM, H);
  xcd_barrier(xb);
  {
    const u16* Bt = P.Wgu + (size_t)layer * 5632 * DM;
    auto epi_gu = [&](int m, int n, float4 vA, float4 vB) {
      int ff = (n >> 6) * 32 + (n & 31);
#pragma unroll
      for (int e = 0; e < 4; ++e) ACT[(size_t)(m + e) * DFF + ff] = f2bf(silu_f(f4get(vA, e)) * f4get(vB, e));
    };
    for (int t = blockIdx.x; t < 1024; t += gridDim.x) {
      int tm = t % (MT / 256), tn = t / (MT / 256);
      gemm_tile<4>(H, DM, Bt, DM, DM, tm * 256, tn * 256, smem, epi_gu);
    }
    for (int u = blockIdx.x; u < 64; u += gridDim.x) {
      int ft = 1024 + (u >> 1);
      int tm = ft % (MT / 256), tn = ft / (MT / 256);
      gemm_tile<2>(H, DM, Bt, DM, DM, tm * 256, tn * 256 + (u & 1) * 128, smem, epi_gu);
    }
  }
  xcd_barrier(xb);
  gemm_residual_phase(P, ACT, DFF, P.Wd + (size_t)layer * DM * DFF, layer, 5, smem);
  xcd_barrier(xb);
}

DI void store_vt4(u16* p, float4 v) { *(uint2*)p = make_uint2(pack2(v.x, v.y), pack2(v.z, v.w)); }

DI void mla_layer(CP P, const XcdBarrier& xb, int layer, int j, char* smem) {
  const size_t MiB = 1048576;
  u16* H = (u16*)P.arena;
  float* RAW = (float*)(P.arena + 24 * MiB);
  u16* QN = (u16*)(P.arena + 63 * MiB);
  u16* Q = (u16*)(P.arena + 75 * MiB);
  u16* Kn = (u16*)(P.arena + 111 * MiB);
  u16* VtP = (u16*)(P.arena + 136 * MiB);
  u16* VtS = (u16*)(P.arena + 152 * MiB);
  u16* O = (u16*)(P.arena + 161 * MiB);
  u16* CK = P.CKVk + (size_t)j * KROWS * 256;
  u16* KR = P.KRk + (size_t)j * KROWS * 64;
  normmod_phase(P, layer, 0, P.in[11] + layer * DM, H, layer == 0);
  xcd_barrier(xb);
  {
    const u16* Bt = P.Wdqkv + (size_t)j * 1024 * DM;
    const int tiles = (MT / 256) * 4;
    for (int t = blockIdx.x; t < tiles; t += gridDim.x) {
      int tm = t % (MT / 256), tn = t / (MT / 256);
      gemm_tile<4>(H, DM, Bt, DM, DM, tm * 256, tn * 256, smem, [&](int m, int n, float4 vA, float4 vB) {
#pragma unroll
        for (int e = 0; e < 4; ++e) {
          if (n < 832) RAW[(size_t)(m + e) * 832 + n] = f4get(vA, e);
          if (n + 32 < 832) RAW[(size_t)(m + e) * 832 + n + 32] = f4get(vB, e);
        }
      });
    }
  }
  xcd_barrier(xb);
  mla_rownorm_phase(P, j, RAW, QN);
  xcd_barrier(xb);
  {
    const u16* Bq = P.Wuq + (size_t)j * 1536 * 512;
    const u16* Bkv = P.Wukv + (size_t)j * 2048 * 256;
    const int T1 = (MT / 256) * 6, T2 = (KROWS / 256) * 8;
    const float qs = 0.07216878364870322f * LOG2E;
    for (int t = blockIdx.x; t < T1 + T2; t += gridDim.x) {
      const bool isq = t < T1;
      int tm, tn; const u16 *Ap, *Bp; int kdim;
      if (isq) { tm = t % (MT / 256); tn = t / (MT / 256); Ap = QN; Bp = Bq; kdim = 512; }
      else { int t2 = t - T1; tm = t2 % (KROWS / 256); tn = t2 / (KROWS / 256); Ap = CK; Bp = Bkv; kdim = 256; }
      gemm_tile<4>(Ap, kdim, Bp, kdim, kdim, tm * 256, tn * 256, smem, [&](int m, int n, float4 vA, float4 vB) {
        if (isq) {
          auto one = [&](int nn, float4 v) {
            int d = nn % 192;
            bool rp = (d >= 128) && (m >= MP);
#pragma unroll
            for (int e = 0; e < 4; ++e) {
              float val = f4get(v, e);
              if (rp) {
                float partner = __shfl_xor(val, 16);
                val = rope1(val, partner, d - 128, (m + e - MP) & 2047);
              }
              Q[(size_t)(m + e) * 1536 + nn] = f2bf(val * qs);
            }
          };
          one(n, vA);
          one(n + 32, vB);
        } else {
          const int R = m;
          auto one = [&](int nn, float4 v) {
            if (nn < 1024) {
#pragma unroll
              for (int e = 0; e < 4; ++e) Kn[(size_t)(R + e) * 1024 + nn] = f2bf(f4get(v, e));
            } else {
              int c = nn - 1024, hh = c >> 7, dv = c & 127;
              if (R < MP) {
                int b = R >> 8, s = R & 255;
                store_vt4(VtP + ((size_t)(b * 8 + hh) * 128 + dv) * 256 + s, v);
              } else {
                int Rp = R - MP; int b = Rp / 2304; int kk = Rp - b * 2304;
                store_vt4(VtS + ((size_t)(b * 8 + hh) * 128 + dv) * 2304 + kk, v);
              }
            }
          };
          one(n, vA);
          one(n + 32, vB);
        }
      });
    }
  }
  xcd_barrier(xb);
  {
    const int NL = 256, NP = 512;
    const int lat_rounds = (NL + (int)gridDim.x - 1) / (int)gridDim.x, pr_rounds = (NP + VGRID - 1) / VGRID;
    for (int j = 0; j < lat_rounds + pr_rounds; ++j) {
      const bool split = j < lat_rounds;
      int b, hh, m0, kbase, ldv, e1; const u16* vt;
      if (split) {
        const int it = (int)blockIdx.x + j * (int)gridDim.x;
        if (it >= NL) continue;
        b = it >> 7; hh = (it >> 4) & 7; int qb = it & 15;
        m0 = MP + b * 2048 + qb * 128; kbase = MP + b * 2304; ldv = 2304; e1 = 2304;
        vt = VtS + (size_t)(b * 8 + hh) * 128 * 2304;
      } else {
        const int i2 = VBLK + (j - lat_rounds) * VGRID;
        if (i2 >= NP) continue;
        b = i2 >> 4; hh = (i2 >> 1) & 7; int qb = i2 & 1;
        m0 = b * 256 + qb * 128; kbase = b * 256; ldv = 256; e1 = 256;
        vt = VtP + (size_t)(b * 8 + hh) * 128 * 256;
      }
      attn_item<128, 64, 128>(Q, 1536, hh * 192, m0, Kn, 1024, hh * 128, KR, kbase, vt, ldv, e1, 0, 0, false, 0, -1e30f, 0.f,
                              O, DM, hh * 128, smem + VHALF * HALF_LDS, split);
    }
  }
  xcd_barrier(xb);
  gemm_residual_phase(P, O, DM, P.Wmo + (size_t)j * DM * DM, layer, 2, smem);
  xcd_barrier(xb);
}

DI void hgrn_layer(CP P, const XcdBarrier& xb, int layer, char* smem) {
  const size_t MiB = 1048576;
  u16* H = (u16*)P.arena;
  u16* Qh = (u16*)(P.arena + 24 * MiB);
  u16* Vh = (u16*)(P.arena + 48 * MiB);
  u16* Gh = (u16*)(P.arena + 72 * MiB);
  f16* LF = (f16*)(P.arena + 96 * MiB);
  u16* OO = (u16*)(P.arena + 144 * MiB);
  normmod_phase(P, layer, 0, P.in[11] + layer * DM, H);
  xcd_barrier(xb);
  {
    const int tiles = (MT / 256) * 20;
    for (int t = blockIdx.x; t < tiles; t += gridDim.x) {
      int tm = t % (MT / 256), tn = t / (MT / 256);
      gemm_tile<4>(H, DM, P.Wh, DM, DM, tm * 256, tn * 256, smem, [&](int m, int n, float4 vA, float4 vB) {
        const int seg = n >> 10;
        const int c = n & 1023;
        const unsigned gi = (unsigned)m * DM + c;
        if (seg == 0 || seg == 4) {
          u16* dst = seg == 0 ? Qh : Gh;
#pragma unroll
          for (int e = 0; e < 4; ++e) {
            dst[gi + e * DM] = f2bf(silu_f(f4get(vA, e)));
            dst[gi + e * DM + 32] = f2bf(silu_f(f4get(vB, e)));
          }
        } else if (seg == 3) {
#pragma unroll
          for (int e = 0; e < 4; ++e) {
            Vh[gi + e * DM] = f2bf(f4get(vA, e));
            Vh[gi + e * DM + 32] = f2bf(f4get(vB, e));
          }
        } else {
          const float lbA = P.lb[(seg - 1) * 1024 + c], lbB = P.lb[(seg - 1) * 1024 + c + 32];
          f16* lf = LF + (size_t)(seg - 1) * MT * DM;
#pragma unroll
          for (int e = 0; e < 4; ++e) {
            float fA = lbA + (1.f - lbA) * sigmoid_f(f4get(vA, e));
            float fB = lbB + (1.f - lbB) * sigmoid_f(f4get(vB, e));
            lf[gi + e * DM] = (f16)__logf(fA);
            lf[gi + e * DM + 32] = (f16)__logf(fB);
          }
        }
      });
    }
  }
  xcd_barrier(xb);
  float* Lbuf = (float*)P.arena;
  float* Dbuf = (float*)(P.arena + (size_t)15 * MiB);
  for (int ph = 0; ph < 2; ++ph) {
    const int nit = ph == 0 ? 512 : 480;
    for (int it = VBLK; it < nit; it += VGRID) {
      int kind, idx;
      if (ph == 0) { if (it < 224) { kind = 1; idx = it; } else { kind = 0; idx = it - 224; } }
      else { if (it < 256) { kind = 2; idx = it; } else { kind = 0; idx = it - 256 + 288; } }
      hgrn_item(P, kind, idx, Qh, Vh, LF, OO, Lbuf, Dbuf, smem + VHALF * HALF_LDS);
    }
    xcd_barrier(xb);
  }
  hgrn_post_phase(P, OO, OO + (size_t)MT * DM, Gh, H);
  xcd_barrier(xb);
  gemm_residual_phase(P, H, DM, P.Who, layer, 2, smem);
  xcd_barrier(xb);
}

DI void swa_layer(CP P, const XcdBarrier& xb, int layer, char* smem) {
  const size_t MiB = 1048576;
  u16* H = (u16*)P.arena;
  u16* Q = (u16*)(P.arena + 24 * MiB);
  u16* VtP2 = (u16*)(P.arena + 48 * MiB);
  u16* O = (u16*)(P.arena + 52 * MiB);
  normmod_phase(P, layer, 0, P.in[11] + layer * DM, H);
  xcd_barrier(xb);
  {
    const int tiles = (MT / 256) * 6;
    const float qs = 0.125f * LOG2E;
    for (int t = blockIdx.x; t < tiles; t += gridDim.x) {
      int tm = t % (MT / 256), tn = t / (MT / 256);
      gemm_tile<4>(H, DM, P.Wsqkv, DM, DM, tm * 256, tn * 256, smem, [&](int m, int n, float4 vA, float4 vB) {
        auto one = [&](int nn, float4 v) {
          const bool lat = m >= MP;
          if (nn < 1280) {
            const bool isq = nn < 1024;
#pragma unroll
            for (int e = 0; e < 4; ++e) {
              float val = f4get(v, e);
              if (!isq && !lat) P.out[OUT_SK + (size_t)(m + e) * 256 + (nn - 1024)] = val;
              if (lat) {
                float partner = __shfl_xor(val, 16);
                val = rope1(val, partner, nn & 63, (m + e - MP) & 2047);
              }
              if (isq) Q[(size_t)(m + e) * DM + nn] = f2bf(val * qs);
              else P.KSk[(size_t)keyrow_of(m + e) * 256 + (nn - 1024)] = f2bf(val);
            }
          } else {
            int c = nn - 1280, kvh = c >> 6, d = c & 63;
            if (!lat) {
#pragma unroll
              for (int e = 0; e < 4; ++e) P.out[OUT_SV + (size_t)(m + e) * 256 + c] = f4get(v, e);
              int b = m >> 8, s = m & 255;
              store_vt4(VtP2 + ((size_t)(b * 4 + kvh) * 64 + d) * 256 + s, v);
            } else {
              int mm = m - MP; int b = mm >> 11, s = mm & 2047;
              store_vt4(P.VtS2 + ((size_t)(b * 4 + kvh) * 64 + d) * 2304 + 256 + s, v);
            }
          }
        };
        one(n, vA);
        one(n + 32, vB);
      });
    }
  }
  xcd_barrier(xb);
  {
    const int NL = 512, NP = 1024;
    for (int it = VBLK; it < NL + NP; it += VGRID) {
      int b, hq, m0, kbase, ldv, lo2 = 0, hi2 = 0, t0 = 0; bool win = false; const u16* vt;
      if (it < NL) {
        b = it >> 8; hq = (it >> 4) & 15; int qb = it & 15;
        t0 = qb * 128;
        int lo = t0 - 128 < 0 ? 0 : t0 - 128;
        int hi = t0 + 256 > 2048 ? 2048 : t0 + 256;
        lo2 = 256 + lo; hi2 = 256 + hi; win = true;
        m0 = MP + b * 2048 + t0; kbase = MP + b * 2304; ldv = 2304;
        vt = P.VtS2 + (size_t)(b * 4 + (hq >> 2)) * 64 * 2304;
      } else {
        int i2 = it - NL;
        b = i2 >> 5; hq = (i2 >> 1) & 15; int qb = i2 & 1;
        m0 = b * 256 + qb * 128; kbase = b * 256; ldv = 256;
        vt = VtP2 + (size_t)(b * 4 + (hq >> 2)) * 64 * 256;
      }
      float sink = P.in[36][hq] * LOG2E;
      attn_item<64, 0, 64>(Q, DM, hq * 64, m0, P.KSk, 256, (hq >> 2) * 64, nullptr, kbase, vt, ldv, 256, lo2, hi2, win, t0, sink, 1.f,
                           O, DM, hq * 64, smem + VHALF * HALF_LDS);
    }
  }
  xcd_barrier(xb);
  gemm_residual_phase(P, O, DM, P.Wso, layer, 2, smem);
  xcd_barrier(xb);
}

__global__ void __launch_bounds__(512, 2) hybrid_mega(Params Pval) {
  CP P = *(const __attribute__((address_space(4))) Params*)__builtin_amdgcn_kernarg_segment_ptr();
  __shared__ __attribute__((aligned(16))) char smem[SMEM_BYTES];
  if (threadIdx.x < 64) g_hbar[threadIdx.x] = 0u;
  g_tidtab[threadIdx.x] = threadIdx.x;
  __shared__ uint4 xb_words;
  cg::grid_group grid = cg::this_grid();
  if (threadIdx.x == 0) xb_words = make_uint4(0u, 0u, 0u, 0u);
  __syncthreads();
  const XcdBarrier xb = xcd_barrier_post(P.bar, (volatile LAS unsigned*)&xb_words);
  phase0(P, smem + VHALF * HALF_LDS);
  grid.sync();
  mla_layer(P, xb, 0, 0, smem);
  ffn_block(P, xb, 0, smem);
  hgrn_layer(P, xb, 1, smem);
  ffn_block(P, xb, 1, smem);
  swa_layer(P, xb, 2, smem);
  ffn_block(P, xb, 2, smem);
  mla_layer(P, xb, 3, 1, smem);
  ffn_block(P, xb, 3, smem);
  final_norm_phase(P);
}

extern "C" void kernel_launch(void* const* d_in, const int* in_sizes, int n_in, void* d_out, int out_size, void* d_ws, size_t ws_size,
                              hipStream_t stream) {
  static int grid_blocks = 0;
  if (!grid_blocks) {
    int dev = 0, cus = 0, per_cu = 0;
    hipGetDevice(&dev);
    hipDeviceGetAttribute(&cus, hipDeviceAttributeMultiprocessorCount, dev);
    hipOccupancyMaxActiveBlocksPerMultiprocessor(&per_cu, hybrid_mega, 512, 0);
    if (per_cu > 1) per_cu = 1;
    grid_blocks = cus * per_cu;
  }
  Params P{};
  for (int i = 0; i < 37; ++i) P.in[i] = (const float*)d_in[i];
  P.out = (float*)d_out;
  char* ws = (char*)d_ws;
  size_t off = 0;
  auto alloc = [&](size_t bytes) { size_t o = off; off += (bytes + 255) & ~(size_t)255; return ws + o; };
  P.Wgu = (u16*)alloc((size_t)4 * 5632 * DM * 2);
  P.Wd = (u16*)alloc((size_t)4 * DM * DFF * 2);
  P.Wdqkv = (u16*)alloc((size_t)2 * 1024 * DM * 2);
  P.Wuq = (u16*)alloc((size_t)2 * 1536 * 512 * 2);
  P.Wukv = (u16*)alloc((size_t)2 * 2048 * 256 * 2);
  P.Wmo = (u16*)alloc((size_t)2 * DM * DM * 2);
  P.Wh = (u16*)alloc((size_t)5120 * DM * 2);
  P.Who = (u16*)alloc((size_t)DM * DM * 2);
  P.Wsqkv = (u16*)alloc((size_t)1536 * DM * 2);
  P.Wso = (u16*)alloc((size_t)DM * DM * 2);
  P.X = (float*)alloc((size_t)MT * DM * 4);
  P.mod = (float*)alloc((size_t)4 * 3 * 6144 * 4);
  P.lb = (float*)alloc(2048 * 4);
  P.CKVk = (u16*)alloc((size_t)2 * KROWS * 256 * 2);
  P.KRk = (u16*)alloc((size_t)2 * KROWS * 64 * 2);
  P.KSk = (u16*)alloc((size_t)KROWS * 256 * 2);
  P.VtS2 = (u16*)alloc((size_t)2 * 4 * 64 * 2304 * 2);
  P.arena = alloc((size_t)192 * 1048576);
  P.bar = (unsigned*)alloc(XCD_BAR_WORDS * 4);
  if (off > ws_size) { fprintf(stderr, "workspace too small: need %zu have %zu\n", off, ws_size); return; }
  hipMemsetAsync(P.bar, 0, XCD_BAR_WORDS * 4, stream);
  void* args[] = {&P};
  hipError_t e = hipLaunchCooperativeKernel((void*)hybrid_mega, dim3(grid_blocks), dim3(512), args, 0, stream);
  if (e != hipSuccess) fprintf(stderr, "cooperative launch failed: %s (grid %d)\n", hipGetErrorString(e), grid_blocks);
}
```

```cpp
#include <hip/hip_runtime.h>
#include <hip/hip_cooperative_groups.h>
#include <cstdio>
namespace cg = cooperative_groups;

typedef unsigned short u16;
typedef _Float16 f16;
using bf16x8 = __attribute__((ext_vector_type(8))) short;
using s16x4  = __attribute__((ext_vector_type(4))) short;
using f32x16 = __attribute__((ext_vector_type(16))) float;
using u32x4  = __attribute__((ext_vector_type(4))) unsigned;
using f32x4  = __attribute__((ext_vector_type(4))) float;
#define DI __device__ __forceinline__
#define MFMA32(a, b, c) __builtin_amdgcn_mfma_f32_32x32x16_bf16((a), (b), (c), 0, 0, 0)

#define MP 8192
#define MS 4096
#define MT 12288
#define DM 1024
#define DFF 2816
#define KROWS 12800
#define LOG2E 1.4426950408889634f
#define SMEM_BYTES 147456

struct Params {
  const float* in[37];
  float* out;
  u16 *Wgu, *Wd, *Wdqkv, *Wuq, *Wukv, *Wmo, *Wh, *Who, *Wsqkv, *Wso;
  float *X, *mod, *lb;
  u16 *CKVk, *KRk, *KSk, *VtS2;
  char* arena;
  unsigned* bar;
};
typedef const __attribute__((address_space(4))) Params& CP;

#define OUT_YP 0
#define OUT_YS 8388608
#define OUT_CKV 12582912
#define OUT_KR 16777216
#define OUT_HG 17825792
#define OUT_SK 26214400
#define OUT_SV 28311552


#define HALF_LDS 73728
#define VTID ((int)(threadIdx.x & 255))
#define VHALF ((int)(threadIdx.x >> 8))
#define VBLK ((int)(blockIdx.x * 2 + (threadIdx.x >> 8)))
#define VGRID ((int)(gridDim.x * 2))
__shared__ unsigned g_hbar[2 * 32];
DI void hbar_impl() {
  asm volatile("s_waitcnt lgkmcnt(0)" ::: "memory");
  if ((threadIdx.x & 63) == 0) {
    unsigned* c = &g_hbar[(threadIdx.x >> 8) * 32];
    const unsigned old = __hip_atomic_fetch_add(c, 1u, __ATOMIC_RELAXED, __HIP_MEMORY_SCOPE_WORKGROUP);
    const unsigned target = (old / 4u + 1u) * 4u;
    while (__hip_atomic_load(c, __ATOMIC_RELAXED, __HIP_MEMORY_SCOPE_WORKGROUP) < target) __builtin_amdgcn_s_sleep(1);
  }
  asm volatile("" ::: "memory");
}
#define HBAR() hbar_impl()
__shared__ int g_tidtab[512];
DI int opq_full() { return ((volatile int*)g_tidtab)[threadIdx.x]; }
DI u16 f2bf(float x) { unsigned u = __float_as_uint(x); u += 0x7fffu + ((u >> 16) & 1u); return (u16)(u >> 16); }
DI float bf2f(u16 v) { return __uint_as_float(((unsigned)v) << 16); }
DI unsigned pack2(float a, float b) { return (unsigned)f2bf(a) | ((unsigned)f2bf(b) << 16); }
DI bf16x8 pack8(float a0, float a1, float a2, float a3, float a4, float a5, float a6, float a7) {
  u32x4 p; p[0] = pack2(a0, a1); p[1] = pack2(a2, a3); p[2] = pack2(a4, a5); p[3] = pack2(a6, a7);
  return __builtin_bit_cast(bf16x8, p);
}
DI float silu_f(float x) { return x * __builtin_amdgcn_rcpf(1.f + __expf(-x)); }
DI float sigmoid_f(float x) { return __builtin_amdgcn_rcpf(1.f + __expf(-x)); }
DI int crow(int i, int h) { return (i & 3) + 8 * (i >> 2) + 4 * h; }
DI int keyrow_of(int m) {
  if (m < MP) return m;
  int mm = m - MP; int b = mm >> 11; int s = mm & 2047;
  return MP + b * 2304 + 256 + s;
}
DI int grp_of(int m) { return m < MP ? 0 : 1 + ((m - MP) >> 11); }
DI float rope1(float v, float partner, int d64, int s) {
  int jj = d64 & 15;
  float pos = (float)((d64 & 32) ? (s & 63) : (s >> 6));
  float inv = __builtin_amdgcn_exp2f(-(float)jj * 0.83048202372184058696f);
  float ang = pos * inv;
  float sn = __sinf(ang), cs = __cosf(ang);
  return (d64 & 16) ? (partner * sn + v * cs) : (v * cs - partner * sn);
}


#define XB_TMO      128
#define XB_XCNT(j)  (256  + 64 * (j))
#define XB_XSUB(j)  (1280 + 64 * (j))
#define XB_XGEN(j)  (2304 + 64 * (j))
#define XB_TOP      3328
#define XB_TOPGEN   3392
#define XCD_BAR_WORDS 3456
#define XB_SPIN_CAP (1u << 18)
#define LAS __attribute__((address_space(3)))
DI unsigned xb_ld(unsigned* p)              { return __hip_atomic_load(p, __ATOMIC_RELAXED, __HIP_MEMORY_SCOPE_AGENT); }
DI unsigned xb_add(unsigned* p, unsigned v) { return __hip_atomic_fetch_add(p, v, __ATOMIC_RELAXED, __HIP_MEMORY_SCOPE_AGENT); }
DI unsigned xb_xcc_id() { return (unsigned)__builtin_amdgcn_s_getreg((3 << 11) | 20) & 0xFu; }
#define XB_SPIN(cond, bar) do { unsigned _sp = 0; while (cond) { __builtin_amdgcn_s_sleep(1); \
    if ((++_sp & 255u) == 0u) { if (xb_ld(&(bar)[XB_TMO])) break; if (_sp > XB_SPIN_CAP) { atomicAdd(&(bar)[XB_TMO], 1u); break; } } } } while (0)
struct XcdBarrier { unsigned* bar; unsigned x; volatile LAS unsigned* st; };
DI XcdBarrier xcd_barrier_post(unsigned* bar, volatile LAS unsigned* st) {
  XcdBarrier b; b.bar = bar; b.x = xb_xcc_id(); b.st = st;
  if (threadIdx.x == 0) (void)xb_add(&bar[XB_XCNT(b.x)], 1u);
  return b;
}
DI void xcd_barrier_complete(unsigned* bar, unsigned x, unsigned& nloc, unsigned& nx) {
  const unsigned G = gridDim.x * gridDim.y * gridDim.z;
  unsigned sum, cnt, mine, sp = 0u;
  for (;;) {
    sum = 0u; cnt = 0u; mine = 0u;
#pragma unroll
    for (unsigned j = 0; j < 16; ++j) { const unsigned c = xb_ld(&bar[XB_XCNT(j)]); sum += c; cnt += (c > 0u) ? 1u : 0u; mine = (j == x) ? c : mine; }
    if (sum == G) break;
    __builtin_amdgcn_s_sleep(1);
    if ((++sp & 255u) == 0u) { if (xb_ld(&bar[XB_TMO])) break; if (sp > XB_SPIN_CAP) { atomicAdd(&bar[XB_TMO], 1u); break; } }
  }
  nloc = mine > 0u ? mine : 1u; nx = cnt > 0u ? cnt : 1u;
}
DI void xcd_barrier(const XcdBarrier& b) {
  asm volatile("s_waitcnt vmcnt(0)" ::: "memory");
  __syncthreads();
  if (threadIdx.x == 0) {
    unsigned* bar = b.bar;
    __builtin_amdgcn_s_waitcnt(0);
    unsigned nloc = b.st[0], nx = b.st[1];
    if (nloc == 0u) { xcd_barrier_complete(bar, b.x, nloc, nx); b.st[0] = nloc; b.st[1] = nx; }
    const unsigned old = xb_add(&bar[XB_XSUB(b.x)], 1u);
    const unsigned gen = old / nloc;
    if (old + 1u == (gen + 1u) * nloc) {
      __builtin_amdgcn_fence(__ATOMIC_RELEASE, "agent");
      asm volatile("s_waitcnt vmcnt(0)" ::: "memory");
      const unsigned og = xb_add(&bar[XB_TOP], 1u);
      const unsigned tg = og / nx;
      if (og + 1u == (tg + 1u) * nx) xb_add(&bar[XB_TOPGEN], 1u);
      else XB_SPIN(xb_ld(&bar[XB_TOPGEN]) == tg, bar);
      __builtin_amdgcn_fence(__ATOMIC_ACQUIRE, "agent");
      xb_add(&bar[XB_XGEN(b.x)], 1u);
      asm volatile("s_waitcnt vmcnt(0)" ::: "memory");
    } else {
      XB_SPIN(xb_ld(&bar[XB_XGEN(b.x)]) == gen, bar);
      __builtin_amdgcn_fence(__ATOMIC_ACQUIRE, "agent");
      asm volatile("s_waitcnt vmcnt(0)" ::: "memory");
    }
  }
  __syncthreads();
}

#define RAW_BARRIER() do { asm volatile("s_waitcnt lgkmcnt(0)" ::: "memory"); __builtin_amdgcn_s_barrier(); asm volatile("" ::: "memory"); } while (0)
template <int NJ, bool GU = false, class Epi>
DI void gemm_tile(const u16* __restrict__ A, int lda, const u16* __restrict__ B, int ldb, int K, int m0, int n0, char* smem, Epi&& epi, u16* gu_out = nullptr) {
  constexpr int BN = 64 * NJ;
  constexpr int NBI = BN / 128;
  constexpr int SA_BYTES = 256 * 64, SB_BYTES = BN * 64, STAGE = SA_BYTES + SB_BYTES;
  constexpr int NLD = 2 + NBI;
  static_assert(NLD == 4 || NLD == 3, "vmcnt immediates below assume this");
  const int tid = opq_full(), lane = tid & 63, w = tid >> 6, r = lane & 31, h = lane >> 5;
  const int wm = w >> 1, wn = w & 1;
  f32x16 acc[2][NJ];
#pragma unroll
  for (int i = 0; i < 2; ++i)
#pragma unroll
    for (int j = 0; j < NJ; ++j)
#pragma unroll
      for (int e = 0; e < 16; ++e) acc[i][j][e] = 0.f;
  const int drow = lane >> 2, dch = (lane & 3) ^ (lane >> 4);
  const u16* ga0 = A + (size_t)(m0 + (w * 2 + 0) * 16 + drow) * lda + dch * 8;
  const u16* ga1 = A + (size_t)(m0 + (w * 2 + 1) * 16 + drow) * lda + dch * 8;
  const u16* gb0 = B + (size_t)(n0 + (w * NBI + 0) * 16 + drow) * ldb + dch * 8;
  const u16* gb1 = B + (size_t)(n0 + (w * NBI + (NBI - 1)) * 16 + drow) * ldb + dch * 8;
  const int nk = K >> 5;
  const int rot = (m0 >> 8) % nk;
  auto issue = [&](int j, int buf) {
    int jj = j < nk ? j : nk - 1;
    int kk = rot + jj; kk = kk >= nk ? kk - nk : kk;
    const int k0 = kk * 32;
    char* sb_ = smem + buf * STAGE;
    __builtin_amdgcn_global_load_lds((const unsigned*)(ga0 + k0), (__attribute__((address_space(3))) unsigned*)(sb_ + (w * 2 + 0) * 1024), 16, 0, 0);
    __builtin_amdgcn_global_load_lds((const unsigned*)(ga1 + k0), (__attribute__((address_space(3))) unsigned*)(sb_ + (w * 2 + 1) * 1024), 16, 0, 0);
    __builtin_amdgcn_global_load_lds((const unsigned*)(gb0 + k0), (__attribute__((address_space(3))) unsigned*)(sb_ + SA_BYTES + (w * NBI + 0) * 1024), 16, 0, 0);
    if (NBI == 2)
      __builtin_amdgcn_global_load_lds((const unsigned*)(gb1 + k0), (__attribute__((address_space(3))) unsigned*)(sb_ + SA_BYTES + (w * NBI + 1) * 1024), 16, 0, 0);
  };
  const unsigned sw = (unsigned)((r >> 2) & 3);
  const unsigned sbase = (unsigned)(size_t)smem;
  const unsigned so0 = ((0u * 2u + (unsigned)h) ^ sw) * 16u, so1 = ((1u * 2u + (unsigned)h) ^ sw) * 16u;
  const unsigned rowA = (unsigned)(wm * 64 + r) * 64u, rowB = (unsigned)SA_BYTES + (unsigned)(wn * 32 * NJ + r) * 64u;
#define LDS_RD(dst, addr, OFF) asm volatile("ds_read_b128 %0, %1 offset:%2" : "=v"(dst) : "v"(addr), "n"(OFF) : "memory")
  __syncthreads();
  issue(0, 0); issue(1, 1); issue(2, 2);
  for (int kt = 0; kt < nk; ++kt) {
    if (NLD == 4) asm volatile("s_waitcnt vmcnt(8)" ::: "memory"); else asm volatile("s_waitcnt vmcnt(6)" ::: "memory");
    RAW_BARRIER();
    issue(kt + 3, (kt + 3) & 3);
    const unsigned st = sbase + (unsigned)(kt & 3) * (unsigned)STAGE;
    const unsigned pa0 = st + rowA + so0, pa1 = st + rowA + so1, pb0 = st + rowB + so0, pb1 = st + rowB + so1;
    bf16x8 a00, a10, a01, a11, b0[NJ], b1[NJ];
    LDS_RD(a00, pa0, 0); LDS_RD(a10, pa0, 2048);
    LDS_RD(b0[0], pb0, 0); LDS_RD(b0[1], pb0, 2048);
    if (NJ == 4) { LDS_RD(b0[NJ - 2], pb0, 4096); LDS_RD(b0[NJ - 1], pb0, 6144); }
    LDS_RD(a01, pa1, 0); LDS_RD(a11, pa1, 2048);
    LDS_RD(b1[0], pb1, 0); LDS_RD(b1[1], pb1, 2048);
    if (NJ == 4) { LDS_RD(b1[NJ - 2], pb1, 4096); LDS_RD(b1[NJ - 1], pb1, 6144); }
    if (NJ == 4) asm volatile("s_waitcnt lgkmcnt(6)" : "+v"(a00), "+v"(a10), "+v"(b0[0]), "+v"(b0[1]), "+v"(b0[NJ - 2]), "+v"(b0[NJ - 1]) :: "memory");
    else asm volatile("s_waitcnt lgkmcnt(4)" : "+v"(a00), "+v"(a10), "+v"(b0[0]), "+v"(b0[1]) :: "memory");
#pragma unroll
    for (int j = 0; j < NJ; ++j) {
      acc[0][j] = MFMA32(a00, b0[j], acc[0][j]);
      acc[1][j] = MFMA32(a10, b0[j], acc[1][j]);
    }
    if (NJ == 4) asm volatile("s_waitcnt lgkmcnt(0)" : "+v"(a01), "+v"(a11), "+v"(b1[0]), "+v"(b1[1]), "+v"(b1[NJ - 2]), "+v"(b1[NJ - 1]) :: "memory");
    else asm volatile("s_waitcnt lgkmcnt(0)" : "+v"(a01), "+v"(a11), "+v"(b1[0]), "+v"(b1[1]) :: "memory");
#pragma unroll
    for (int j = 0; j < NJ; ++j) {
      acc[0][j] = MFMA32(a01, b1[j], acc[0][j]);
      acc[1][j] = MFMA32(a11, b1[j], acc[1][j]);
    }
  }
  asm volatile("s_waitcnt vmcnt(0)" ::: "memory");
  if constexpr (GU && NJ == 4) {
    char* slab = smem + 4 * STAGE + w * 2048;
    const int ffb = ((n0 + wn * 128) >> 6) * 32;
#pragma unroll
    for (int i = 0; i < 2; ++i)
#pragma unroll
      for (int gp = 0; gp < 2; ++gp) {
#pragma unroll
        for (int gg = 0; gg < 2; ++gg)
#pragma unroll
          for (int jp = 0; jp < 2; ++jp)
#pragma unroll
            for (int q = 0; q < 4; ++q) {
              const int g = gp * 2 + gg;
              const float gv = acc[i][2 * jp][4 * g + q], uv = acc[i][2 * jp + 1][4 * g + q];
              *(u16*)(slab + (8 * gg + 4 * h + q) * 128 + (jp * 32 + r) * 2) = f2bf(silu_f(gv) * uv);
            }
#pragma unroll
        for (int p = 0; p < 2; ++p) {
          const int row = (lane >> 3) + 8 * p, ch = lane & 7;
          const uint4 v = *(const uint4*)(slab + row * 128 + ch * 16);
          const int m = m0 + wm * 64 + i * 32 + 16 * gp + row;
          *(uint4*)(gu_out + (size_t)m * DFF + ffb + ch * 8) = v;
        }
      }
    return;
  }
#pragma unroll
  for (int i = 0; i < 2; ++i)
#pragma unroll
    for (int g = 0; g < 4; ++g) {
      int m = m0 + wm * 64 + i * 32 + 8 * g + 4 * h;
#pragma unroll
      for (int jp = 0; jp < NJ / 2; ++jp) {
        float4 vA = make_float4(acc[i][2 * jp][4 * g], acc[i][2 * jp][4 * g + 1], acc[i][2 * jp][4 * g + 2], acc[i][2 * jp][4 * g + 3]);
        float4 vB = make_float4(acc[i][2 * jp + 1][4 * g], acc[i][2 * jp + 1][4 * g + 1], acc[i][2 * jp + 1][4 * g + 2], acc[i][2 * jp + 1][4 * g + 3]);
        epi(m, n0 + wn * 32 * NJ + jp * 64 + r, vA, vB);
      }
    }
}

DI float f4get(const float4& v, int e) { return e == 0 ? v.x : e == 1 ? v.y : e == 2 ? v.z : v.w; }

struct ConvP { const float* src; u16* dst; int N, ldd, row0, mode, k0, n0; };
DI ConvP conv_params(CP P, int t) {
  const float* src = nullptr; u16* dst = nullptr; int K = 0, N = 64, ldd = 0, row0 = 0, mode = 0; bool found = false;
#define TRY(SRC, KK, NN, DST, LDD, ROW0, MODE)                                   \
  if (!found) { int nt_ = ((KK) / 64) * ((NN) / 64);                              \
    if (t < nt_) { src = (SRC); K = (KK); N = (NN); dst = (DST); ldd = (LDD); row0 = (ROW0); mode = (MODE); found = true; } else t -= nt_; }
#pragma unroll
  for (int i = 0; i < 4; ++i) {
    TRY(P.in[13] + (size_t)i * DM * DFF, DM, DFF, P.Wgu + (size_t)i * 5632 * DM, DM, 0, 1)
    TRY(P.in[14] + (size_t)i * DM * DFF, DM, DFF, P.Wgu + (size_t)i * 5632 * DM, DM, 0, 2)
    TRY(P.in[15] + (size_t)i * DFF * DM, DFF, DM, P.Wd + (size_t)i * DM * DFF, DFF, 0, 0)
  }
#pragma unroll
  for (int j = 0; j < 2; ++j) {
    TRY(P.in[17] + (size_t)j * DM * 512, DM, 512, P.Wdqkv + (size_t)j * 1024 * DM, DM, 0, 0)
    TRY(P.in[20] + (size_t)j * DM * 320, DM, 320, P.Wdqkv + (size_t)j * 1024 * DM, DM, 512, 0)
    TRY(P.in[19] + (size_t)j * 512 * 1536, 512, 1536, P.Wuq + (size_t)j * 1536 * 512, 512, 0, 0)
    TRY(P.in[22] + (size_t)j * 256 * 1024, 256, 1024, P.Wukv + (size_t)j * 2048 * 256, 256, 0, 0)
    TRY(P.in[23] + (size_t)j * 256 * 1024, 256, 1024, P.Wukv + (size_t)j * 2048 * 256, 256, 1024, 0)
    TRY(P.in[24] + (size_t)j * DM * DM, DM, DM, P.Wmo + (size_t)j * DM * DM, DM, 0, 0)
  }
  TRY(P.in[25], DM, DM, P.Wh, DM, 0, 0)
  TRY(P.in[26], DM, DM, P.Wh, DM, 1024, 0)
  TRY(P.in[26] + (size_t)DM * DM, DM, DM, P.Wh, DM, 2048, 0)
  TRY(P.in[27], DM, DM, P.Wh, DM, 3072, 0)
  TRY(P.in[28], DM, DM, P.Wh, DM, 4096, 0)
  TRY(P.in[30], DM, DM, P.Who, DM, 0, 0)
  TRY(P.in[32], DM, DM, P.Wsqkv, DM, 0, 0)
  TRY(P.in[33], DM, 256, P.Wsqkv, DM, 1024, 0)
  TRY(P.in[34], DM, 256, P.Wsqkv, DM, 1280, 0)
  TRY(P.in[35], DM, DM, P.Wso, DM, 0, 0)
#undef TRY
  const int ntn = N / 64;
  const int tk = t / ntn, tn = t - tk * ntn;
  ConvP c; c.src = src; c.dst = dst; c.N = N; c.ldd = ldd; c.row0 = row0; c.mode = mode; c.k0 = tk * 64; c.n0 = tn * 64;
  return c;
}
#define CONV_LOAD(c, v0, v1, v2, v3, tid) do {                                                                         \
    const float* sp_ = (c).src + (size_t)((c).k0 + ((tid) >> 4)) * (c).N + (c).n0 + ((tid) & 15) * 4;                   \
    v0 = *(const f32x4*)(sp_); v1 = *(const f32x4*)(sp_ + (size_t)16 * (c).N);                                          \
    v2 = *(const f32x4*)(sp_ + (size_t)32 * (c).N); v3 = *(const f32x4*)(sp_ + (size_t)48 * (c).N); } while (0)
DI void conv_store(const ConvP& c, f32x4 v0, f32x4 v1, f32x4 v2, f32x4 v3, int tid, char* smem) {
  u16* t = (u16*)smem;
  HBAR();
  const int k = tid >> 4, n4 = (tid & 15) * 4;
#pragma unroll
  for (int j = 0; j < 4; ++j) {
    t[(n4 + j) * 72 + k] = f2bf(v0[j]);
    t[(n4 + j) * 72 + k + 16] = f2bf(v1[j]);
    t[(n4 + j) * 72 + k + 32] = f2bf(v2[j]);
    t[(n4 + j) * 72 + k + 48] = f2bf(v3[j]);
  }
  HBAR();
  const int n = tid >> 2, q = tid & 3;
  const int nn = c.n0 + n;
  const int row = c.mode == 0 ? c.row0 + nn : ((nn >> 5) * 64 + (c.mode == 2 ? 32 : 0) + (nn & 31));
  uint4 a = *(const uint4*)(t + n * 72 + q * 16);
  uint4 b = *(const uint4*)(t + n * 72 + q * 16 + 8);
  u16* d = c.dst + (size_t)row * c.ldd + c.k0 + q * 16;
  *(uint4*)d = a;
  *(uint4*)(d + 8) = b;
}
#define N_CONV_TILES 12192

DI void adaln_item(CP P, int it, char* smem) {
  const int i = it / 96, cb = it - i * 96;
  float* s = (float*)smem;
  const int tid = (opq_full() & 255);
  HBAR();
  for (int e = tid; e < 3072; e += 256) {
    int rr = e >> 10, k = e & 1023;
    float c = rr == 0 ? P.in[8][k] : P.in[7][(rr - 1) * 1024 + k];
    s[e] = silu_f(c);
  }
  HBAR();
  const int kg = tid >> 4, c4 = (tid & 15) * 4;
  const float* wp = P.in[9] + ((size_t)i * 1024 + kg * 64) * 6144 + cb * 64 + c4;
  f32x4 a0 = {0.f, 0.f, 0.f, 0.f}, a1 = a0, a2 = a0;
#pragma unroll 16
  for (int k = 0; k < 64; ++k) {
    f32x4 wv = *(const f32x4*)(wp + (size_t)k * 6144);
    a0 += s[kg * 64 + k] * wv;
    a1 += s[1024 + kg * 64 + k] * wv;
    a2 += s[2048 + kg * 64 + k] * wv;
  }
  float* red = s + 3072;
  *(f32x4*)(red + (kg * 3 + 0) * 64 + c4) = a0;
  *(f32x4*)(red + (kg * 3 + 1) * 64 + c4) = a1;
  *(f32x4*)(red + (kg * 3 + 2) * 64 + c4) = a2;
  HBAR();
  if (tid < 192) {
    const int rr = tid >> 6, c2 = tid & 63;
    float sum = 0.f;
#pragma unroll
    for (int g = 0; g < 16; ++g) sum += red[(g * 3 + rr) * 64 + c2];
    const int nn = cb * 64 + c2;
    P.mod[(size_t)(i * 3 + rr) * 6144 + nn] = sum + P.in[10][i * 6144 + nn];
  }
}

DI void misc_item(CP P, int it) {
  const int tid = (opq_full() & 255);
  for (int p = 0; p < 8; ++p) {
    int e = it * 2048 + p * 256 + tid;
    if (e < 262144) {
      int c = e & 255, l = (e >> 8) & 255, j = (e >> 16) & 1, b = e >> 17;
      P.CKVk[((size_t)j * KROWS + MP + b * 2304 + l) * 256 + c] = f2bf(P.in[2][e]);
    } else if (e < 262144 + 65536) {
      int e2 = e - 262144;
      int c = e2 & 63, l = (e2 >> 6) & 255, j = (e2 >> 14) & 1, b = e2 >> 15;
      P.KRk[((size_t)j * KROWS + MP + b * 2304 + l) * 64 + c] = f2bf(P.in[3][e2]);
    } else if (e < 262144 + 65536 + 131072) {
      int e2 = e - 327680;
      int c = e2 & 255, l = (e2 >> 8) & 255, b = e2 >> 16;
      P.KSk[((size_t)MP + b * 2304 + l) * 256 + c] = f2bf(P.in[5][e2]);
    } else if (e < 589824) {
      int e2 = e - 458752;
      int d = e2 & 63, kvh = (e2 >> 6) & 3, l = (e2 >> 8) & 255, b = e2 >> 16;
      P.VtS2[((size_t)(b * 4 + kvh) * 64 + d) * 2304 + l] = f2bf(P.in[6][e2]);
    }
  }
}
#define N_MISC_ITEMS 288

DI void phase0(CP P, char* smem) {
  const int tid = (opq_full() & 255);
  const int vb = VBLK, vg = VGRID;
  {
    int t = vb;
    ConvP cur; f32x4 v0, v1, v2, v3;
    if (t < N_CONV_TILES) { cur = conv_params(P, t); CONV_LOAD(cur, v0, v1, v2, v3, tid); }
    for (; t < N_CONV_TILES; t += vg) {
      const int tn = t + vg;
      ConvP nx = cur; f32x4 w0 = v0, w1 = v1, w2 = v2, w3 = v3;
      if (tn < N_CONV_TILES) { nx = conv_params(P, tn); CONV_LOAD(nx, w0, w1, w2, w3, tid); }
      conv_store(cur, v0, v1, v2, v3, tid, smem);
      cur = nx; v0 = w0; v1 = w1; v2 = w2; v3 = w3;
    }
  }
  for (int it = vg - 1 - vb; it < 384; it += vg) adaln_item(P, it, smem);
  for (int it = vb; it < N_MISC_ITEMS + 2; it += vg) {
    if (it < N_MISC_ITEMS) { misc_item(P, it); continue; }
    if (it == N_MISC_ITEMS) {
      for (int e = tid; e < 2048; e += 256) {
        int d = e >> 10, kd = e & 1023;
        const float* lg = P.in[31] + (size_t)d * 4 * 1024 + kd;
        float l0 = lg[0], l1 = lg[1024], l2 = lg[2048], l3 = lg[3072];
        float mx = fmaxf(fmaxf(l0, l1), fmaxf(l2, l3));
        float e0 = __expf(l0 - mx), e1 = __expf(l1 - mx), e2 = __expf(l2 - mx), e3 = __expf(l3 - mx);
        P.lb[e] = e1 / (e0 + e1 + e2 + e3);
      }
    } else {
      for (int e = tid; e < 2 * 192 * 1024 / 8; e += 256) {
        int j = e / (192 * 128), rem = e - j * 192 * 128;
        *(uint4*)(P.Wdqkv + (size_t)j * 1024 * DM + (size_t)832 * DM + (size_t)rem * 8) = make_uint4(0, 0, 0, 0);
      }
    }
  }
}

DI float wave_sum(float v) {
#pragma unroll
  for (int o = 32; o >= 1; o >>= 1) v += __shfl_xor(v, o);
  return v;
}

DI void normmod_phase(CP P, int layer, int which  , const float* gain, u16* H, bool first = false) {
  const int tid_ = (opq_full() & 255); const int lane = tid_ & 63, w = tid_ >> 6;
  const int stride = VGRID * 4;
  int m = VBLK * 4 + w;
  f32x4 g[4], v[4];
#pragma unroll
  for (int i = 0; i < 4; ++i) g[i] = *(const f32x4*)(gain + (i * 64 + lane) * 4);
  if (m < MT) {
    const float* x = first ? (m < MP ? P.in[0] + (size_t)m * DM : P.in[1] + (size_t)(m - MP) * DM) : P.X + (size_t)m * DM;
#pragma unroll
    for (int i = 0; i < 4; ++i) v[i] = *(const f32x4*)(x + (i * 64 + lane) * 4);
  }
  for (; m < MT; m += stride) {
    const int mn = m + stride;
    f32x4 nv[4];
#pragma unroll
    for (int i = 0; i < 4; ++i) nv[i] = v[i];
    if (mn < MT) {
      const float* xn = first ? (mn < MP ? P.in[0] + (size_t)mn * DM : P.in[1] + (size_t)(mn - MP) * DM) : P.X + (size_t)mn * DM;
#pragma unroll
      for (int i = 0; i < 4; ++i) nv[i] = *(const f32x4*)(xn + (i * 64 + lane) * 4);
    }
    const float* md = P.mod + (size_t)(layer * 3 + grp_of(m)) * 6144 + which * 3072;
    f32x4 sh[4], sc[4];
#pragma unroll
    for (int i = 0; i < 4; ++i) { sh[i] = *(const f32x4*)(md + (i * 64 + lane) * 4); sc[i] = *(const f32x4*)(md + 1024 + (i * 64 + lane) * 4); }
    float ss = 0.f;
#pragma unroll
    for (int i = 0; i < 4; ++i) ss += v[i].x * v[i].x + v[i].y * v[i].y + v[i].z * v[i].z + v[i].w * v[i].w;
    if (first) {
#pragma unroll
      for (int i = 0; i < 4; ++i) *(f32x4*)(P.X + (size_t)m * DM + (i * 64 + lane) * 4) = v[i];
    }
    ss = wave_sum(ss);
    const float rstd = rsqrtf(ss * (1.f / DM) + 1e-6f);
#pragma unroll
    for (int i = 0; i < 4; ++i) {
      const int c = (i * 64 + lane) * 4;
      f32x4 o = v[i] * rstd * g[i] * (1.f + sc[i]) + sh[i];
      *(uint2*)(H + (size_t)m * DM + c) = make_uint2(pack2(o.x, o.y), pack2(o.z, o.w));
    }
#pragma unroll
    for (int i = 0; i < 4; ++i) v[i] = nv[i];
  }
}

DI void final_norm_phase(CP P) {
  const int tid_ = (opq_full() & 255); const int lane = tid_ & 63, w = tid_ >> 6;
  for (int m = VBLK * 4 + w; m < MT; m += VGRID * 4) {
    const float* x = P.X + (size_t)m * DM;
    f32x4 v[4]; float ss = 0.f;
#pragma unroll
    for (int i = 0; i < 4; ++i) { v[i] = *(const f32x4*)(x + (i * 64 + lane) * 4); ss += v[i].x * v[i].x + v[i].y * v[i].y + v[i].z * v[i].z + v[i].w * v[i].w; }
    ss = wave_sum(ss);
    float rstd = rsqrtf(ss * (1.f / DM) + 1e-6f);
#pragma unroll
    for (int i = 0; i < 4; ++i) {
      int c = (i * 64 + lane) * 4;
      float4 g = *(const float4*)(P.in[16] + c);
      *(float4*)(P.out + (size_t)m * DM + c) = make_float4(v[i].x * rstd * g.x, v[i].y * rstd * g.y, v[i].z * rstd * g.z, v[i].w * rstd * g.w);
    }
  }
}

DI void mla_rownorm_phase(CP P, int j, const float* RAW, u16* QN) {
  const int tid_ = (opq_full() & 255); const int lane = tid_ & 63, w = tid_ >> 6;
  const float* qg = P.in[18] + j * 512;
  const float* kg = P.in[21] + j * 256;
  u16* CK = P.CKVk + (size_t)j * KROWS * 256;
  u16* KR = P.KRk + (size_t)j * KROWS * 64;
  for (int m = VBLK * 4 + w; m < MT; m += VGRID * 4) {
    const float* x = RAW + (size_t)m * 832;
    float4 q0 = *(const float4*)(x + lane * 4), q1 = *(const float4*)(x + 256 + lane * 4);
    float4 kv = *(const float4*)(x + 512 + lane * 4);
    float kr = x[768 + lane];
    float sq = q0.x * q0.x + q0.y * q0.y + q0.z * q0.z + q0.w * q0.w + q1.x * q1.x + q1.y * q1.y + q1.z * q1.z + q1.w * q1.w;
    float sk = kv.x * kv.x + kv.y * kv.y + kv.z * kv.z + kv.w * kv.w;
    sq = wave_sum(sq); sk = wave_sum(sk);
    float rq = rsqrtf(sq * (1.f / 512.f) + 1e-6f), rk = rsqrtf(sk * (1.f / 256.f) + 1e-6f);
    float4 g0 = *(const float4*)(qg + lane * 4), g1 = *(const float4*)(qg + 256 + lane * 4), g2 = *(const float4*)(kg + lane * 4);
    *(uint2*)(QN + (size_t)m * 512 + lane * 4) = make_uint2(pack2(q0.x * rq * g0.x, q0.y * rq * g0.y), pack2(q0.z * rq * g0.z, q0.w * rq * g0.w));
    *(uint2*)(QN + (size_t)m * 512 + 256 + lane * 4) = make_uint2(pack2(q1.x * rq * g1.x, q1.y * rq * g1.y), pack2(q1.z * rq * g1.z, q1.w * rq * g1.w));
    float4 c = make_float4(kv.x * rk * g2.x, kv.y * rk * g2.y, kv.z * rk * g2.z, kv.w * rk * g2.w);
    const int kr_row = keyrow_of(m);
    *(uint2*)(CK + (size_t)kr_row * 256 + lane * 4) = make_uint2(pack2(c.x, c.y), pack2(c.z, c.w));
    float partner = __shfl_xor(kr, 16);
    if (m < MP) {
      int b = m >> 8, s = m & 255;
      *(float4*)(P.out + OUT_CKV + ((size_t)(b * 2 + j) * 256 + s) * 256 + lane * 4) = c;
      P.out[OUT_KR + ((size_t)(b * 2 + j) * 256 + s) * 64 + lane] = kr;
      KR[(size_t)kr_row * 64 + lane] = f2bf(kr);
    } else {
      int s = (m - MP) & 2047;
      KR[(size_t)kr_row * 64 + lane] = f2bf(rope1(kr, partner, lane, s));
    }
  }
}

DI void hgrn_post_phase(CP P, const u16* Of, const u16* Ob, const u16* Gh, u16* A2) {
  const int tid_ = (opq_full() & 255); const int lane = tid_ & 63, w = tid_ >> 6;
  for (int m = VBLK * 4 + w; m < MT; m += VGRID * 4) {
#pragma unroll
    for (int i = 0; i < 4; ++i) {
      int c = (i * 64 + lane) * 4;
      uint2 a = *(const uint2*)(Of + (size_t)m * DM + c), b = *(const uint2*)(Ob + (size_t)m * DM + c), g = *(const uint2*)(Gh + (size_t)m * DM + c);
      float o0 = bf2f((u16)(a.x & 0xffff)) + bf2f((u16)(b.x & 0xffff));
      float o1 = bf2f((u16)(a.x >> 16)) + bf2f((u16)(b.x >> 16));
      float o2 = bf2f((u16)(a.y & 0xffff)) + bf2f((u16)(b.y & 0xffff));
      float o3 = bf2f((u16)(a.y >> 16)) + bf2f((u16)(b.y >> 16));
      float ss = o0 * o0 + o1 * o1 + o2 * o2 + o3 * o3;
#pragma unroll
      for (int o = 16; o >= 1; o >>= 1) ss += __shfl_xor(ss, o);
      float rstd = rsqrtf(ss * (1.f / 128.f) + 1e-6f);
      float4 gn = *(const float4*)(P.in[29] + (c & 127));
      o0 = o0 * rstd * gn.x * bf2f((u16)(g.x & 0xffff));
      o1 = o1 * rstd * gn.y * bf2f((u16)(g.x >> 16));
      o2 = o2 * rstd * gn.z * bf2f((u16)(g.y & 0xffff));
      o3 = o3 * rstd * gn.w * bf2f((u16)(g.y >> 16));
      *(uint2*)(A2 + (size_t)m * DM + c) = make_uint2(pack2(o0, o1), pack2(o2, o3));
    }
  }
}

template <int DKN, int DKR, int DV>
DI void attn_item(const u16* __restrict__ Q, int ldq, int qoff, int m0,
                  const u16* __restrict__ Kn, int ldk, int koff, const u16* __restrict__ Kr, int kbase,
                  const u16* __restrict__ Vt, int ldv,
                  int e1, int lo2, int hi2, bool win, int t0, float m_init, float l_init,
                  u16* __restrict__ O, int ldo, int ooff, char* smem, bool split = false) {
  constexpr int DK = DKN + DKR;
  constexpr int KST = DK * 2 + 16;
  constexpr int KBYTES = 32 * KST;
  constexpr int VBYTES = DV * 80;
  constexpr int STAGE = KBYTES + VBYTES;
  constexpr int KCH = DK / 8;
  constexpr int NKL = (32 * KCH) / 256;
  constexpr int NVL = (DV * 4) / 256;
  const int tfull = opq_full();
  const int tid = tfull & 255, vh = tfull >> 8, lane = tid & 63, w = tid >> 6, r = lane & 31, h = lane >> 5;

  bf16x8 qf[DK / 16];
  {
    const u16* qp = Q + (size_t)(m0 + w * 32 + r) * ldq + qoff + h * 8;
#pragma unroll
    for (int ks = 0; ks < DK / 16; ++ks) qf[ks] = *(const bf16x8*)(qp + ks * 16);
  }
  f32x16 o[DV / 32];
#pragma unroll
  for (int d = 0; d < DV / 32; ++d)
#pragma unroll
    for (int e = 0; e < 16; ++e) o[d][e] = 0.f;
  float mrun = m_init, lrun = (h == 0) ? l_init : 0.f;

  const int n1 = e1 >> 5;
  const int nsteps = n1 + ((hi2 - lo2) >> 5);
  const int sbeg = split ? vh * (nsteps >> 1) : 0;
  const int send = split ? sbeg + (nsteps >> 1) : nsteps;
  u32x4 rk[NKL], rv[NVL];
  auto gload = [&](int st) {
    const int kk = st < n1 ? st * 32 : lo2 + (st - n1) * 32;
#pragma unroll
    for (int i = 0; i < NKL; ++i) {
      int c = tid + 256 * i;
      int row = c / KCH, cc = c - row * KCH;
      size_t kr_ = (size_t)(kbase + kk + row);
      const u16* src = (cc < DKN / 8) ? (Kn + kr_ * ldk + koff + cc * 8) : (Kr + kr_ * 64 + (cc - DKN / 8) * 8);
      rk[i] = *(const u32x4*)src;
    }
#pragma unroll
    for (int i = 0; i < NVL; ++i) {
      int c = tid + 256 * i;
      int row = c >> 2, cc = c & 3;
      rv[i] = *(const u32x4*)(Vt + (size_t)row * ldv + kk + cc * 8);
    }
  };
  gload(sbeg);
  HBAR();
  for (int st = sbeg; st < send; ++st) {
    char* sk = smem + ((st - sbeg) & 1) * STAGE;
    char* sv = sk + KBYTES;
#pragma unroll
    for (int i = 0; i < NKL; ++i) {
      int c = tid + 256 * i;
      int row = c / KCH, cc = c - row * KCH;
      *(u32x4*)(sk + row * KST + cc * 16) = rk[i];
    }
#pragma unroll
    for (int i = 0; i < NVL; ++i) {
      int c = tid + 256 * i;
      int row = c >> 2, cc = c & 3;
      *(u32x4*)(sv + row * 80 + cc * 16) = rv[i];
    }
    HBAR();
    const int kk = st < n1 ? st * 32 : lo2 + (st - n1) * 32;
    if (st + 1 < send) gload(st + 1);
    f32x16 x;
#pragma unroll
    for (int e = 0; e < 16; ++e) x[e] = 0.f;
    const char* pk = sk + r * KST + h * 16;
#pragma unroll
    for (int ks = 0; ks < DK / 16; ++ks) {
      bf16x8 a = *(const bf16x8*)(pk + ks * 32);
      x = MFMA32(a, qf[ks], x);
    }
    if (win && kk >= 256) {
      const int t = t0 + w * 32 + r;
      const int sb = kk - 256;
#pragma unroll
      for (int e = 0; e < 16; ++e) {
        int dlt = t - (sb + crow(e, h));
        if (dlt > 128 || dlt < -128) x[e] = -1e30f;
      }
    }
    float mloc = x[0];
#pragma unroll
    for (int e = 1; e < 16; ++e) mloc = fmaxf(mloc, x[e]);
    mloc = fmaxf(mloc, __shfl_xor(mloc, 32));
    const float mnew = fmaxf(mrun, mloc);
    const float alpha = __builtin_amdgcn_exp2f(mrun - mnew);
    mrun = mnew;
    float psum = 0.f;
#pragma unroll
    for (int e = 0; e < 16; ++e) { x[e] = __builtin_amdgcn_exp2f(x[e] - mnew); psum += x[e]; }
    lrun = lrun * alpha + psum;
#pragma unroll
    for (int d = 0; d < DV / 32; ++d)
#pragma unroll
      for (int e = 0; e < 16; ++e) o[d][e] *= alpha;
    bf16x8 pb0 = pack8(x[0], x[1], x[2], x[3], x[4], x[5], x[6], x[7]);
    bf16x8 pb1 = pack8(x[8], x[9], x[10], x[11], x[12], x[13], x[14], x[15]);
#pragma unroll
    for (int d = 0; d < DV / 32; ++d) {
      const char* pv = sv + (d * 32 + r) * 80 + h * 8;
      s16x4 lo0 = *(const s16x4*)(pv), hi0 = *(const s16x4*)(pv + 16);
      s16x4 lo1 = *(const s16x4*)(pv + 32), hi1 = *(const s16x4*)(pv + 48);
      bf16x8 av0 = __builtin_shufflevector(lo0, hi0, 0, 1, 2, 3, 4, 5, 6, 7);
      bf16x8 av1 = __builtin_shufflevector(lo1, hi1, 0, 1, 2, 3, 4, 5, 6, 7);
      o[d] = MFMA32(av0, pb0, o[d]);
      o[d] = MFMA32(av1, pb1, o[d]);
    }
  }
  if (split) {
    float* xch = (float*)(vh ? smem : smem + HALF_LDS);
    HBAR();
    if (vh == 1) {
#pragma unroll
      for (int d = 0; d < DV / 32; ++d)
#pragma unroll
        for (int e = 0; e < 16; ++e) xch[(d * 16 + e) * 256 + tid] = o[d][e];
      xch[(DV / 2) * 256 + tid] = mrun;
      xch[(DV / 2 + 1) * 256 + tid] = lrun;
    }
    __syncthreads();
    if (vh == 0) {
      const float m1 = xch[(DV / 2) * 256 + tid], l1 = xch[(DV / 2 + 1) * 256 + tid];
      const float mnew = fmaxf(mrun, m1);
      const float a0 = __builtin_amdgcn_exp2f(mrun - mnew), a1 = __builtin_amdgcn_exp2f(m1 - mnew);
      lrun = lrun * a0 + l1 * a1;
#pragma unroll
      for (int d = 0; d < DV / 32; ++d)
#pragma unroll
        for (int e = 0; e < 16; ++e) o[d][e] = o[d][e] * a0 + xch[(d * 16 + e) * 256 + tid] * a1;
    }
    __syncthreads();
    if (vh == 1) return;
  }
  const float ltot = lrun + __shfl_xor(lrun, 32);
  const float inv = 1.f / ltot;
  u16* op = O + (size_t)(m0 + w * 32 + r) * ldo + ooff;
#pragma unroll
  for (int d = 0; d < DV / 32; ++d)
#pragma unroll
    for (int g = 0; g < 4; ++g)
      *(uint2*)(op + d * 32 + 8 * g + 4 * h) = make_uint2(pack2(o[d][4 * g] * inv, o[d][4 * g + 1] * inv), pack2(o[d][4 * g + 2] * inv, o[d][4 * g + 3] * inv));
}

DI void hgrn_item(CP P, int kind, int idx, const u16* Qh, const u16* Vh, const f16* LF, u16* Oout, float* Lbuf, float* Dbuf, char* smem) {
  const int tid = (opq_full() & 255), lane = tid & 63, w = tid >> 6, r = lane & 31, h = lane >> 5;
  int S, mb, hh, dir, bp = 0, bl = 0, seg = 0, q = 0;
  if (kind == 0) { bp = idx >> 4; hh = (idx >> 1) & 7; dir = idx & 1; S = 256; mb = bp * 256; }
  else {
    if (kind == 1) { q = idx / 7; seg = idx - q * 7; } else { q = idx >> 3; seg = idx & 7; }
    bl = q >> 4; hh = (q >> 1) & 7; dir = q & 1; S = 2048; mb = MP + bl * 2048;
  }
  const int u0 = seg * 256;
  const bool write_o = kind != 1;
  char* Qs = smem;
  char* Ks = smem + 8704;
  char* KsT = smem + 17408;
  char* VT = smem + 27648;
  float* erho = (float*)(smem + 37888);
  float* elast = erho + 128;
  float* exch = elast + 128;
  const f16* lf_base = LF + (size_t)dir * MT * DM;
  u16* Od = Oout + (size_t)dir * MT * DM;

  f32x16 st[4];
  if (kind != 2) {
#pragma unroll
    for (int t = 0; t < 4; ++t)
#pragma unroll
      for (int e = 0; e < 16; ++e) st[t][e] = 0.f;
  } else {
    const float* s0 = P.in[4] + ((size_t)((bl * 2 + dir) * 8 + hh)) * 128 * 128;
#pragma unroll
    for (int t = 0; t < 4; ++t)
#pragma unroll
      for (int e = 0; e < 16; ++e) st[t][e] = s0[(size_t)(32 * t + crow(e, h)) * 128 + 32 * w + r];
#pragma unroll 1
    for (int j = 0; j < seg; ++j) {
      const float* Lj = Lbuf + (size_t)(q * 7 + j) * 16384;
      const float* Dj = Dbuf + (size_t)(q * 7 + j) * 128;
#pragma unroll
      for (int t = 0; t < 4; ++t)
#pragma unroll
        for (int g = 0; g < 4; ++g) {
          int k = 32 * t + 8 * g + 4 * h;
          float4 dj = *(const float4*)(Dj + k);
          const float* lp = Lj + (size_t)k * 128 + 32 * w + r;
          st[t][4 * g] = dj.x * st[t][4 * g] + lp[0];
          st[t][4 * g + 1] = dj.y * st[t][4 * g + 1] + lp[128];
          st[t][4 * g + 2] = dj.z * st[t][4 * g + 2] + lp[256];
          st[t][4 * g + 3] = dj.w * st[t][4 * g + 3] + lp[384];
        }
    }
  }
  float dlog = 0.f;
  const int kd = tid & 127, th = tid >> 7;
  const int nch = 8;
  typedef _Float16 f16x2 __attribute__((ext_vector_type(2)));
  typedef unsigned short u16x2 __attribute__((ext_vector_type(2)));
  f16x2 plf[8]; u16x2 pq[8], pv[8];
#pragma unroll
  for (int t16 = 0; t16 < 16; ++t16) {
    int t = th * 16 + t16;
    int tok = dir ? (S - 1 - (u0 + t)) : (u0 + t);
    size_t gi = (size_t)(mb + tok) * DM + hh * 128 + kd;
    plf[t16 >> 1][t16 & 1] = lf_base[gi]; pq[t16 >> 1][t16 & 1] = Qh[gi]; pv[t16 >> 1][t16 & 1] = Vh[gi];
  }
  for (int c = 0; c < nch; ++c) {
    HBAR();
    float bc[16];
    float run = 0.f;
#pragma unroll
    for (int t16 = 0; t16 < 16; ++t16) {
      run += (float)plf[t16 >> 1][t16 & 1];
      bc[t16] = run;
    }
    if (th == 0) exch[kd] = run;
    HBAR();
    const float rho = exch[kd];
    if (th == 1) {
#pragma unroll
      for (int t16 = 0; t16 < 16; ++t16) bc[t16] += rho;
      elast[kd] = __expf(bc[15] - rho);
      erho[kd] = __expf(rho);
      dlog += bc[15];
    }
#pragma unroll
    for (int t16 = 0; t16 < 16; ++t16) {
      int t = th * 16 + t16;
      float q = bf2f(pq[t16 >> 1][t16 & 1]);
      float kval = 1.f - __expf((float)plf[t16 >> 1][t16 & 1]);
      float dq = bc[t16] - rho;
      u16 qb = f2bf(q * __expf(dq));
      u16 kb = f2bf(kval * __expf(-dq));
      *(u16*)(Qs + t * 272 + kd * 2) = qb;
      *(u16*)(Ks + t * 272 + kd * 2) = kb;
      *(u16*)(KsT + kd * 80 + t * 2) = kb;
      *(u16*)(VT + kd * 80 + t * 2) = pv[t16 >> 1][t16 & 1];
    }
    if (c + 1 < nch) {
#pragma unroll
      for (int t16 = 0; t16 < 16; ++t16) {
        int t = th * 16 + t16;
        int tok = dir ? (S - 1 - (u0 + (c + 1) * 32 + t)) : (u0 + (c + 1) * 32 + t);
        size_t gi = (size_t)(mb + tok) * DM + hh * 128 + kd;
        plf[t16 >> 1][t16 & 1] = lf_base[gi]; pq[t16 >> 1][t16 & 1] = Qh[gi]; pv[t16 >> 1][t16 & 1] = Vh[gi];
      }
    }
    HBAR();
#pragma unroll
    for (int t = 0; t < 4; ++t)
#pragma unroll
      for (int g = 0; g < 4; ++g) {
        float4 er = *(const float4*)(erho + 32 * t + 8 * g + 4 * h);
        st[t][4 * g] *= er.x; st[t][4 * g + 1] *= er.y; st[t][4 * g + 2] *= er.z; st[t][4 * g + 3] *= er.w;
      }
    if (write_o) {
      f32x16 x;
#pragma unroll
      for (int e = 0; e < 16; ++e) x[e] = 0.f;
#pragma unroll
      for (int ks = 0; ks < 8; ++ks) {
        bf16x8 a = *(const bf16x8*)(Ks + r * 272 + ks * 32 + h * 16);
        bf16x8 b = *(const bf16x8*)(Qs + r * 272 + ks * 32 + h * 16);
        x = MFMA32(a, b, x);
      }
#pragma unroll
      for (int e = 0; e < 16; ++e) if (crow(e, h) > r) x[e] = 0.f;
      f32x16 oacc;
#pragma unroll
      for (int e = 0; e < 16; ++e) oacc[e] = 0.f;
#pragma unroll
      for (int t = 0; t < 4; ++t) {
        bf16x8 sb0 = pack8(st[t][0], st[t][1], st[t][2], st[t][3], st[t][4], st[t][5], st[t][6], st[t][7]);
        bf16x8 sb1 = pack8(st[t][8], st[t][9], st[t][10], st[t][11], st[t][12], st[t][13], st[t][14], st[t][15]);
        const char* pq = Qs + r * 272 + (32 * t + 4 * h) * 2;
        s16x4 lo0 = *(const s16x4*)(pq), hi0 = *(const s16x4*)(pq + 16);
        s16x4 lo1 = *(const s16x4*)(pq + 32), hi1 = *(const s16x4*)(pq + 48);
        bf16x8 qa0 = __builtin_shufflevector(lo0, hi0, 0, 1, 2, 3, 4, 5, 6, 7);
        bf16x8 qa1 = __builtin_shufflevector(lo1, hi1, 0, 1, 2, 3, 4, 5, 6, 7);
        oacc = MFMA32(qa0, sb0, oacc);
        oacc = MFMA32(qa1, sb1, oacc);
      }
      {
        bf16x8 xa0 = pack8(x[0], x[1], x[2], x[3], x[4], x[5], x[6], x[7]);
        bf16x8 xa1 = pack8(x[8], x[9], x[10], x[11], x[12], x[13], x[14], x[15]);
        const char* pv = VT + (32 * w + r) * 80 + h * 8;
        s16x4 lo0 = *(const s16x4*)(pv), hi0 = *(const s16x4*)(pv + 16);
        s16x4 lo1 = *(const s16x4*)(pv + 32), hi1 = *(const s16x4*)(pv + 48);
        bf16x8 vb0 = __builtin_shufflevector(lo0, hi0, 0, 1, 2, 3, 4, 5, 6, 7);
        bf16x8 vb1 = __builtin_shufflevector(lo1, hi1, 0, 1, 2, 3, 4, 5, 6, 7);
        oacc = MFMA32(xa0, vb0, oacc);
        oacc = MFMA32(xa1, vb1, oacc);
      }
#pragma unroll
      for (int e = 0; e < 16; ++e) {
        int t = crow(e, h);
        int tok = dir ? (S - 1 - (u0 + c * 32 + t)) : (u0 + c * 32 + t);
        Od[(size_t)(mb + tok) * DM + hh * 128 + 32 * w + r] = f2bf(oacc[e]);
      }
    }
    {
      const char* pv = VT + (32 * w + r) * 80 + h * 16;
      bf16x8 vn0 = *(const bf16x8*)(pv), vn1 = *(const bf16x8*)(pv + 32);
#pragma unroll
      for (int t = 0; t < 4; ++t) {
        const char* pk = KsT + (32 * t + r) * 80 + h * 16;
        bf16x8 ka0 = *(const bf16x8*)(pk), ka1 = *(const bf16x8*)(pk + 32);
        st[t] = MFMA32(ka0, vn0, st[t]);
        st[t] = MFMA32(ka1, vn1, st[t]);
#pragma unroll
        for (int g = 0; g < 4; ++g) {
          float4 el = *(const float4*)(elast + 32 * t + 8 * g + 4 * h);
          st[t][4 * g] *= el.x; st[t][4 * g + 1] *= el.y; st[t][4 * g + 2] *= el.z; st[t][4 * g + 3] *= el.w;
        }
      }
    }
  }
  if (kind == 0) {
    float* so = P.out + OUT_HG + ((size_t)((bp * 2 + dir) * 8 + hh)) * 128 * 128;
#pragma unroll
    for (int t = 0; t < 4; ++t)
#pragma unroll
      for (int e = 0; e < 16; ++e) so[(size_t)(32 * t + crow(e, h)) * 128 + 32 * w + r] = st[t][e];
  } else if (kind == 1) {
    float* so = Lbuf + (size_t)idx * 16384;
#pragma unroll
    for (int t = 0; t < 4; ++t)
#pragma unroll
      for (int e = 0; e < 16; ++e) so[(size_t)(32 * t + crow(e, h)) * 128 + 32 * w + r] = st[t][e];
    if (th == 1) Dbuf[(size_t)idx * 128 + kd] = __expf(dlog);
  }
}

DI void gemm_residual_phase(CP P, const u16* A, int K, const u16* Bt, int layer, int which  , char* smem) {
  const int tiles = (MT / 256) * (DM / 256);
  for (int t = blockIdx.x; t < tiles; t += gridDim.x) {
    int tm = t % (MT / 256), tn = t / (MT / 256);
    gemm_tile<4>(A, K, Bt, K, K, tm * 256, tn * 256, smem, [&](int m, int n, float4 vA, float4 vB) {
      const float* gate = P.mod + (size_t)(layer * 3 + grp_of(m)) * 6144 + which * 1024;
      float gA = gate[n], gB = gate[n + 32];
#pragma unroll
      for (int e = 0; e < 4; ++e) {
        float* xp = P.X + (size_t)(m + e) * DM + n;
        xp[0] += gA * f4get(vA, e);
        xp[32] += gB * f4get(vB, e);
      }
    });
  }
}

DI void ffn_block(CP P, const XcdBarrier& xb, int layer, char* smem) {
  u16* H = (u16*)P.arena;
  u16* ACT = (u16*)(P.arena + (size_t)24 * 1048576);
  normmod_phase(P, layer, 1, P.in[12] + layer * DM, H);
  xcd_barrier(xb);
  {
    const u16* Bt = P.Wgu + (size_t)layer * 5632 * DM;
    auto epi_gu = [&](int m, int n, float4 vA, float4 vB) {
      int ff = (n >> 6) * 32 + (n & 31);
#pragma unroll
      for (int e = 0; e < 4; ++e) ACT[(size_t)(m + e) * DFF + ff] = f2bf(silu_f(f4get(vA, e)) * f4get(vB, e));
    };
    for (int t = blockIdx.x; t < 1024; t += gridDim.x) {
      int tm = t % (MT / 256), tn = t / (MT / 256);
      gemm_tile<4, true>(H, DM, Bt, DM, DM, tm * 256, tn * 256, smem, epi_gu, ACT);
    }
    for (int u = blockIdx.x; u < 64; u += gridDim.x) {
      int ft = 1024 + (u >> 1);
      int tm = ft % (MT / 256), tn = ft / (MT / 256);
      gemm_tile<2>(H, DM, Bt, DM, DM, tm * 256, tn * 256 + (u & 1) * 128, smem, epi_gu);
    }
  }
  xcd_barrier(xb);
  gemm_residual_phase(P, ACT, DFF, P.Wd + (size_t)layer * DM * DFF, layer, 5, smem);
  xcd_barrier(xb);
}

DI void store_vt4(u16* p, float4 v) { *(uint2*)p = make_uint2(pack2(v.x, v.y), pack2(v.z, v.w)); }

DI void mla_layer(CP P, const XcdBarrier& xb, int layer, int j, char* smem) {
  const size_t MiB = 1048576;
  u16* H = (u16*)P.arena;
  float* RAW = (float*)(P.arena + 24 * MiB);
  u16* QN = (u16*)(P.arena + 63 * MiB);
  u16* Q = (u16*)(P.arena + 75 * MiB);
  u16* Kn = (u16*)(P.arena + 111 * MiB);
  u16* VtP = (u16*)(P.arena + 136 * MiB);
  u16* VtS = (u16*)(P.arena + 152 * MiB);
  u16* O = (u16*)(P.arena + 161 * MiB);
  u16* CK = P.CKVk + (size_t)j * KROWS * 256;
  u16* KR = P.KRk + (size_t)j * KROWS * 64;
  normmod_phase(P, layer, 0, P.in[11] + layer * DM, H, layer == 0);
  xcd_barrier(xb);
  {
    const u16* Bt = P.Wdqkv + (size_t)j * 1024 * DM;
    const int tiles = (MT / 256) * 4;
    for (int t = blockIdx.x; t < tiles; t += gridDim.x) {
      int tm = t % (MT / 256), tn = t / (MT / 256);
      gemm_tile<4>(H, DM, Bt, DM, DM, tm * 256, tn * 256, smem, [&](int m, int n, float4 vA, float4 vB) {
#pragma unroll
        for (int e = 0; e < 4; ++e) {
          if (n < 832) RAW[(size_t)(m + e) * 832 + n] = f4get(vA, e);
          if (n + 32 < 832) RAW[(size_t)(m + e) * 832 + n + 32] = f4get(vB, e);
        }
      });
    }
  }
  xcd_barrier(xb);
  mla_rownorm_phase(P, j, RAW, QN);
  xcd_barrier(xb);
  {
    const u16* Bq = P.Wuq + (size_t)j * 1536 * 512;
    const u16* Bkv = P.Wukv + (size_t)j * 2048 * 256;
    const int T1 = (MT / 256) * 6, T2 = (KROWS / 256) * 8;
    const float qs = 0.07216878364870322f * LOG2E;
    for (int t = blockIdx.x; t < T1 + T2; t += gridDim.x) {
      const bool isq = t < T1;
      int tm, tn; const u16 *Ap, *Bp; int kdim;
      if (isq) { tm = t % (MT / 256); tn = t / (MT / 256); Ap = QN; Bp = Bq; kdim = 512; }
      else { int t2 = t - T1; tm = t2 % (KROWS / 256); tn = t2 / (KROWS / 256); Ap = CK; Bp = Bkv; kdim = 256; }
      gemm_tile<4>(Ap, kdim, Bp, kdim, kdim, tm * 256, tn * 256, smem, [&](int m, int n, float4 vA, float4 vB) {
        if (isq) {
          auto one = [&](int nn, float4 v) {
            int d = nn % 192;
            bool rp = (d >= 128) && (m >= MP);
#pragma unroll
            for (int e = 0; e < 4; ++e) {
              float val = f4get(v, e);
              if (rp) {
                float partner = __shfl_xor(val, 16);
                val = rope1(val, partner, d - 128, (m + e - MP) & 2047);
              }
              Q[(size_t)(m + e) * 1536 + nn] = f2bf(val * qs);
            }
          };
          one(n, vA);
          one(n + 32, vB);
        } else {
          const int R = m;
          auto one = [&](int nn, float4 v) {
            if (nn < 1024) {
#pragma unroll
              for (int e = 0; e < 4; ++e) Kn[(size_t)(R + e) * 1024 + nn] = f2bf(f4get(v, e));
            } else {
              int c = nn - 1024, hh = c >> 7, dv = c & 127;
              if (R < MP) {
                int b = R >> 8, s = R & 255;
                store_vt4(VtP + ((size_t)(b * 8 + hh) * 128 + dv) * 256 + s, v);
              } else {
                int Rp = R - MP; int b = Rp / 2304; int kk = Rp - b * 2304;
                store_vt4(VtS + ((size_t)(b * 8 + hh) * 128 + dv) * 2304 + kk, v);
              }
            }
          };
          one(n, vA);
          one(n + 32, vB);
        }
      });
    }
  }
  xcd_barrier(xb);
  {
    const int NL = 256, NP = 512;
    const int lat_rounds = (NL + (int)gridDim.x - 1) / (int)gridDim.x, pr_rounds = (NP + VGRID - 1) / VGRID;
    for (int j = 0; j < lat_rounds + pr_rounds; ++j) {
      const bool split = j < lat_rounds;
      int b, hh, m0, kbase, ldv, e1; const u16* vt;
      if (split) {
        const int it = (int)blockIdx.x + j * (int)gridDim.x;
        if (it >= NL) continue;
        b = it >> 7; hh = (it >> 4) & 7; int qb = it & 15;
        m0 = MP + b * 2048 + qb * 128; kbase = MP + b * 2304; ldv = 2304; e1 = 2304;
        vt = VtS + (size_t)(b * 8 + hh) * 128 * 2304;
      } else {
        const int i2 = VBLK + (j - lat_rounds) * VGRID;
        if (i2 >= NP) continue;
        b = i2 >> 4; hh = (i2 >> 1) & 7; int qb = i2 & 1;
        m0 = b * 256 + qb * 128; kbase = b * 256; ldv = 256; e1 = 256;
        vt = VtP + (size_t)(b * 8 + hh) * 128 * 256;
      }
      attn_item<128, 64, 128>(Q, 1536, hh * 192, m0, Kn, 1024, hh * 128, KR, kbase, vt, ldv, e1, 0, 0, false, 0, -1e30f, 0.f,
                              O, DM, hh * 128, smem + VHALF * HALF_LDS, split);
    }
  }
  xcd_barrier(xb);
  gemm_residual_phase(P, O, DM, P.Wmo + (size_t)j * DM * DM, layer, 2, smem);
  xcd_barrier(xb);
}

DI void hgrn_layer(CP P, const XcdBarrier& xb, int layer, char* smem) {
  const size_t MiB = 1048576;
  u16* H = (u16*)P.arena;
  u16* Qh = (u16*)(P.arena + 24 * MiB);
  u16* Vh = (u16*)(P.arena + 48 * MiB);
  u16* Gh = (u16*)(P.arena + 72 * MiB);
  f16* LF = (f16*)(P.arena + 96 * MiB);
  u16* OO = (u16*)(P.arena + 144 * MiB);
  normmod_phase(P, layer, 0, P.in[11] + layer * DM, H);
  xcd_barrier(xb);
  {
    const int tiles = (MT / 256) * 20;
    for (int t = blockIdx.x; t < tiles; t += gridDim.x) {
      int tm = t % (MT / 256), tn = t / (MT / 256);
      gemm_tile<4>(H, DM, P.Wh, DM, DM, tm * 256, tn * 256, smem, [&](int m, int n, float4 vA, float4 vB) {
        const int seg = n >> 10;
        const int c = n & 1023;
        const unsigned gi = (unsigned)m * DM + c;
        if (seg == 0 || seg == 4) {
          u16* dst = seg == 0 ? Qh : Gh;
#pragma unroll
          for (int e = 0; e < 4; ++e) {
            dst[gi + e * DM] = f2bf(silu_f(f4get(vA, e)));
            dst[gi + e * DM + 32] = f2bf(silu_f(f4get(vB, e)));
          }
        } else if (seg == 3) {
#pragma unroll
          for (int e = 0; e < 4; ++e) {
            Vh[gi + e * DM] = f2bf(f4get(vA, e));
            Vh[gi + e * DM + 32] = f2bf(f4get(vB, e));
          }
        } else {
          const float lbA = P.lb[(seg - 1) * 1024 + c], lbB = P.lb[(seg - 1) * 1024 + c + 32];
          f16* lf = LF + (size_t)(seg - 1) * MT * DM;
#pragma unroll
          for (int e = 0; e < 4; ++e) {
            float fA = lbA + (1.f - lbA) * sigmoid_f(f4get(vA, e));
            float fB = lbB + (1.f - lbB) * sigmoid_f(f4get(vB, e));
            lf[gi + e * DM] = (f16)__logf(fA);
            lf[gi + e * DM + 32] = (f16)__logf(fB);
          }
        }
      });
    }
  }
  xcd_barrier(xb);
  float* Lbuf = (float*)P.arena;
  float* Dbuf = (float*)(P.arena + (size_t)15 * MiB);
  for (int ph = 0; ph < 2; ++ph) {
    const int nit = ph == 0 ? 512 : 480;
    for (int it = VBLK; it < nit; it += VGRID) {
      int kind, idx;
      if (ph == 0) { if (it < 224) { kind = 1; idx = it; } else { kind = 0; idx = it - 224; } }
      else { if (it < 256) { kind = 2; idx = it; } else { kind = 0; idx = it - 256 + 288; } }
      hgrn_item(P, kind, idx, Qh, Vh, LF, OO, Lbuf, Dbuf, smem + VHALF * HALF_LDS);
    }
    xcd_barrier(xb);
  }
  hgrn_post_phase(P, OO, OO + (size_t)MT * DM, Gh, H);
  xcd_barrier(xb);
  gemm_residual_phase(P, H, DM, P.Who, layer, 2, smem);
  xcd_barrier(xb);
}

DI void swa_layer(CP P, const XcdBarrier& xb, int layer, char* smem) {
  const size_t MiB = 1048576;
  u16* H = (u16*)P.arena;
  u16* Q = (u16*)(P.arena + 24 * MiB);
  u16* VtP2 = (u16*)(P.arena + 48 * MiB);
  u16* O = (u16*)(P.arena + 52 * MiB);
  normmod_phase(P, layer, 0, P.in[11] + layer * DM, H);
  xcd_barrier(xb);
  {
    const int tiles = (MT / 256) * 6;
    const float qs = 0.125f * LOG2E;
    for (int t = blockIdx.x; t < tiles; t += gridDim.x) {
      int tm = t % (MT / 256), tn = t / (MT / 256);
      gemm_tile<4>(H, DM, P.Wsqkv, DM, DM, tm * 256, tn * 256, smem, [&](int m, int n, float4 vA, float4 vB) {
        auto one = [&](int nn, float4 v) {
          const bool lat = m >= MP;
          if (nn < 1280) {
            const bool isq = nn < 1024;
#pragma unroll
            for (int e = 0; e < 4; ++e) {
              float val = f4get(v, e);
              if (!isq && !lat) P.out[OUT_SK + (size_t)(m + e) * 256 + (nn - 1024)] = val;
              if (lat) {
                float partner = __shfl_xor(val, 16);
                val = rope1(val, partner, nn & 63, (m + e - MP) & 2047);
              }
              if (isq) Q[(size_t)(m + e) * DM + nn] = f2bf(val * qs);
              else P.KSk[(size_t)keyrow_of(m + e) * 256 + (nn - 1024)] = f2bf(val);
            }
          } else {
            int c = nn - 1280, kvh = c >> 6, d = c & 63;
            if (!lat) {
#pragma unroll
              for (int e = 0; e < 4; ++e) P.out[OUT_SV + (size_t)(m + e) * 256 + c] = f4get(v, e);
              int b = m >> 8, s = m & 255;
              store_vt4(VtP2 + ((size_t)(b * 4 + kvh) * 64 + d) * 256 + s, v);
            } else {
              int mm = m - MP; int b = mm >> 11, s = mm & 2047;
              store_vt4(P.VtS2 + ((size_t)(b * 4 + kvh) * 64 + d) * 2304 + 256 + s, v);
            }
          }
        };
        one(n, vA);
        one(n + 32, vB);
      });
    }
  }
  xcd_barrier(xb);
  {
    const int NL = 512, NP = 1024;
    for (int it = VBLK; it < NL + NP; it += VGRID) {
      int b, hq, m0, kbase, ldv, lo2 = 0, hi2 = 0, t0 = 0; bool win = false; const u16* vt;
      if (it < NL) {
        b = it >> 8; hq = (it >> 4) & 15; int qb = it & 15;
        t0 = qb * 128;
        int lo = t0 - 128 < 0 ? 0 : t0 - 128;
        int hi = t0 + 256 > 2048 ? 2048 : t0 + 256;
        lo2 = 256 + lo; hi2 = 256 + hi; win = true;
        m0 = MP + b * 2048 + t0; kbase = MP + b * 2304; ldv = 2304;
        vt = P.VtS2 + (size_t)(b * 4 + (hq >> 2)) * 64 * 2304;
      } else {
        int i2 = it - NL;
        b = i2 >> 5; hq = (i2 >> 1) & 15; int qb = i2 & 1;
        m0 = b * 256 + qb * 128; kbase = b * 256; ldv = 256;
        vt = VtP2 + (size_t)(b * 4 + (hq >> 2)) * 64 * 256;
      }
      float sink = P.in[36][hq] * LOG2E;
      attn_item<64, 0, 64>(Q, DM, hq * 64, m0, P.KSk, 256, (hq >> 2) * 64, nullptr, kbase, vt, ldv, 256, lo2, hi2, win, t0, sink, 1.f,
                           O, DM, hq * 64, smem + VHALF * HALF_LDS);
    }
  }
  xcd_barrier(xb);
  gemm_residual_phase(P, O, DM, P.Wso, layer, 2, smem);
  xcd_barrier(xb);
}

__global__ void __launch_bounds__(512, 2) hybrid_mega(Params Pval) {
  CP P = *(const __attribute__((address_space(4))) Params*)__builtin_amdgcn_kernarg_segment_ptr();
  __shared__ __attribute__((aligned(16))) char smem[SMEM_BYTES];
  if (threadIdx.x < 64) g_hbar[threadIdx.x] = 0u;
  g_tidtab[threadIdx.x] = threadIdx.x;
  __shared__ uint4 xb_words;
  cg::grid_group grid = cg::this_grid();
  if (threadIdx.x == 0) xb_words = make_uint4(0u, 0u, 0u, 0u);
  __syncthreads();
  const XcdBarrier xb = xcd_barrier_post(P.bar, (volatile LAS unsigned*)&xb_words);
  phase0(P, smem + VHALF * HALF_LDS);
  grid.sync();
  mla_layer(P, xb, 0, 0, smem);
  ffn_block(P, xb, 0, smem);
  hgrn_layer(P, xb, 1, smem);
  ffn_block(P, xb, 1, smem);
  swa_layer(P, xb, 2, smem);
  ffn_block(P, xb, 2, smem);
  mla_layer(P, xb, 3, 1, smem);
  ffn_block(P, xb, 3, smem);
  final_norm_phase(P);
}

extern "C" void kernel_launch(void* const* d_in, const int* in_sizes, int n_in, void* d_out, int out_size, void* d_ws, size_t ws_size,
                              hipStream_t stream) {
  static int grid_blocks = 0;
  if (!grid_blocks) {
    int dev = 0, cus = 0, per_cu = 0;
    hipGetDevice(&dev);
    hipDeviceGetAttribute(&cus, hipDeviceAttributeMultiprocessorCount, dev);
    hipOccupancyMaxActiveBlocksPerMultiprocessor(&per_cu, hybrid_mega, 512, 0);
    if (per_cu > 1) per_cu = 1;
    grid_blocks = cus * per_cu;
  }
  Params P{};
  for (int i = 0; i < 37; ++i) P.in[i] = (const float*)d_in[i];
  P.out = (float*)d_out;
  char* ws = (char*)d_ws;
  size_t off = 0;
  auto alloc = [&](size_t bytes) { size_t o = off; off += (bytes + 255) & ~(size_t)255; return ws + o; };
  P.Wgu = (u16*)alloc((size_t)4 * 5632 * DM * 2);
  P.Wd = (u16*)alloc((size_t)4 * DM * DFF * 2);
  P.Wdqkv = (u16*)alloc((size_t)2 * 1024 * DM * 2);
  P.Wuq = (u16*)alloc((size_t)2 * 1536 * 512 * 2);
  P.Wukv = (u16*)alloc((size_t)2 * 2048 * 256 * 2);
  P.Wmo = (u16*)alloc((size_t)2 * DM * DM * 2);
  P.Wh = (u16*)alloc((size_t)5120 * DM * 2);
  P.Who = (u16*)alloc((size_t)DM * DM * 2);
  P.Wsqkv = (u16*)alloc((size_t)1536 * DM * 2);
  P.Wso = (u16*)alloc((size_t)DM * DM * 2);
  P.X = (float*)alloc((size_t)MT * DM * 4);
  P.mod = (float*)alloc((size_t)4 * 3 * 6144 * 4);
  P.lb = (float*)alloc(2048 * 4);
  P.CKVk = (u16*)alloc((size_t)2 * KROWS * 256 * 2);
  P.KRk = (u16*)alloc((size_t)2 * KROWS * 64 * 2);
  P.KSk = (u16*)alloc((size_t)KROWS * 256 * 2);
  P.VtS2 = (u16*)alloc((size_t)2 * 4 * 64 * 2304 * 2);
  P.arena = alloc((size_t)192 * 1048576);
  P.bar = (unsigned*)alloc(XCD_BAR_WORDS * 4);
  if (off > ws_size) { fprintf(stderr, "workspace too small: need %zu have %zu\n", off, ws_size); return; }
  hipMemsetAsync(P.bar, 0, XCD_BAR_WORDS * 4, stream);
  void* args[] = {&P};
  hipError_t e = hipLaunchCooperativeKernel((void*)hybrid_mega, dim3(grid_blocks), dim3(512), args, 0, stream);
  if (e != hipSuccess) fprintf(stderr, "cooperative launch failed: %s (grid %d)\n", hipGetErrorString(e), grid_blocks);
}
```

```cpp
#include <hip/hip_runtime.h>
#include <hip/hip_cooperative_groups.h>
#include <cstdio>
namespace cg = cooperative_groups;

typedef unsigned short u16;
typedef _Float16 f16;
using bf16x8 = __attribute__((ext_vector_type(8))) short;
using s16x4  = __attribute__((ext_vector_type(4))) short;
using f32x16 = __attribute__((ext_vector_type(16))) float;
using u32x4  = __attribute__((ext_vector_type(4))) unsigned;
using f32x4  = __attribute__((ext_vector_type(4))) float;
#define DI __device__ __forceinline__
#define MFMA32(a, b, c) __builtin_amdgcn_mfma_f32_32x32x16_bf16((a), (b), (c), 0, 0, 0)

#define MP 8192
#define MS 4096
#define MT 12288
#define DM 1024
#define DFF 2816
#define KROWS 12800
#define LOG2E 1.4426950408889634f
#define SMEM_BYTES 147456

struct Params {
  const float* in[37];
  float* out;
  u16 *Wgu, *Wd, *Wdqkv, *Wuq, *Wukv, *Wmo, *Wh, *Who, *Wsqkv, *Wso;
  u16* X;
  float *mod, *lb;
  u16 *CKVk, *KRk, *KSk, *VtS2;
  char* arena;
  unsigned* bar;
};
typedef const __attribute__((address_space(4))) Params& CP;

#define OUT_YP 0
#define OUT_YS 8388608
#define OUT_CKV 12582912
#define OUT_KR 16777216
#define OUT_HG 17825792
#define OUT_SK 26214400
#define OUT_SV 28311552


#define HALF_LDS 73728
#define VTID ((int)(threadIdx.x & 255))
#define VHALF ((int)(threadIdx.x >> 8))
#define VBLK ((int)(blockIdx.x * 2 + (threadIdx.x >> 8)))
#define VGRID ((int)(gridDim.x * 2))
__shared__ unsigned g_hbar[2 * 32];
DI void hbar_impl() {
  asm volatile("s_waitcnt lgkmcnt(0)" ::: "memory");
  if ((threadIdx.x & 63) == 0) {
    unsigned* c = &g_hbar[(threadIdx.x >> 8) * 32];
    const unsigned old = __hip_atomic_fetch_add(c, 1u, __ATOMIC_RELAXED, __HIP_MEMORY_SCOPE_WORKGROUP);
    const unsigned target = (old / 4u + 1u) * 4u;
    while (__hip_atomic_load(c, __ATOMIC_RELAXED, __HIP_MEMORY_SCOPE_WORKGROUP) < target) __builtin_amdgcn_s_sleep(1);
  }
  asm volatile("" ::: "memory");
}
#define HBAR() hbar_impl()
__shared__ int g_tidtab[512];
DI int opq_full() { return ((volatile int*)g_tidtab)[threadIdx.x]; }
DI u16 f2bf(float x) { unsigned u = __float_as_uint(x); u += 0x7fffu + ((u >> 16) & 1u); return (u16)(u >> 16); }
DI float bf2f(u16 v) { return __uint_as_float(((unsigned)v) << 16); }
DI f32x4 ldx4(const u16* p) { const uint2 u = *(const uint2*)p; f32x4 r; r.x = __uint_as_float(u.x << 16); r.y = __uint_as_float(u.x & 0xffff0000u); r.z = __uint_as_float(u.y << 16); r.w = __uint_as_float(u.y & 0xffff0000u); return r; }
DI unsigned pack2(float a, float b) { return (unsigned)f2bf(a) | ((unsigned)f2bf(b) << 16); }
DI bf16x8 pack8(float a0, float a1, float a2, float a3, float a4, float a5, float a6, float a7) {
  u32x4 p; p[0] = pack2(a0, a1); p[1] = pack2(a2, a3); p[2] = pack2(a4, a5); p[3] = pack2(a6, a7);
  return __builtin_bit_cast(bf16x8, p);
}
DI float silu_f(float x) { return x * __builtin_amdgcn_rcpf(1.f + __expf(-x)); }
DI float sigmoid_f(float x) { return __builtin_amdgcn_rcpf(1.f + __expf(-x)); }
DI int crow(int i, int h) { return (i & 3) + 8 * (i >> 2) + 4 * h; }
DI int keyrow_of(int m) {
  if (m < MP) return m;
  int mm = m - MP; int b = mm >> 11; int s = mm & 2047;
  return MP + b * 2304 + 256 + s;
}
DI int grp_of(int m) { return m < MP ? 0 : 1 + ((m - MP) >> 11); }
DI float rope1(float v, float partner, int d64, int s) {
  int jj = d64 & 15;
  float pos = (float)((d64 & 32) ? (s & 63) : (s >> 6));
  float inv = __builtin_amdgcn_exp2f(-(float)jj * 0.83048202372184058696f);
  float ang = pos * inv;
  float sn = __sinf(ang), cs = __cosf(ang);
  return (d64 & 16) ? (partner * sn + v * cs) : (v * cs - partner * sn);
}


#define XB_TMO      128
#define XB_XCNT(j)  (256  + 64 * (j))
#define XB_XSUB(j)  (1280 + 64 * (j))
#define XB_XGEN(j)  (2304 + 64 * (j))
#define XB_TOP      3328
#define XB_TOPGEN   3392
#define XCD_BAR_WORDS 3456
#define XB_SPIN_CAP (1u << 18)
#define LAS __attribute__((address_space(3)))
DI unsigned xb_ld(unsigned* p)              { return __hip_atomic_load(p, __ATOMIC_RELAXED, __HIP_MEMORY_SCOPE_AGENT); }
DI unsigned xb_add(unsigned* p, unsigned v) { return __hip_atomic_fetch_add(p, v, __ATOMIC_RELAXED, __HIP_MEMORY_SCOPE_AGENT); }
DI unsigned xb_xcc_id() { return (unsigned)__builtin_amdgcn_s_getreg((3 << 11) | 20) & 0xFu; }
#define XB_SPIN(cond, bar) do { unsigned _sp = 0; while (cond) { __builtin_amdgcn_s_sleep(1); \
    if ((++_sp & 255u) == 0u) { if (xb_ld(&(bar)[XB_TMO])) break; if (_sp > XB_SPIN_CAP) { atomicAdd(&(bar)[XB_TMO], 1u); break; } } } } while (0)
struct XcdBarrier { unsigned* bar; unsigned x; volatile LAS unsigned* st; };
DI XcdBarrier xcd_barrier_post(unsigned* bar, volatile LAS unsigned* st) {
  XcdBarrier b; b.bar = bar; b.x = xb_xcc_id(); b.st = st;
  if (threadIdx.x == 0) (void)xb_add(&bar[XB_XCNT(b.x)], 1u);
  return b;
}
DI void xcd_barrier_complete(unsigned* bar, unsigned x, unsigned& nloc, unsigned& nx) {
  const unsigned G = gridDim.x * gridDim.y * gridDim.z;
  unsigned sum, cnt, mine, sp = 0u;
  for (;;) {
    sum = 0u; cnt = 0u; mine = 0u;
#pragma unroll
    for (unsigned j = 0; j < 16; ++j) { const unsigned c = xb_ld(&bar[XB_XCNT(j)]); sum += c; cnt += (c > 0u) ? 1u : 0u; mine = (j == x) ? c : mine; }
    if (sum == G) break;
    __builtin_amdgcn_s_sleep(1);
    if ((++sp & 255u) == 0u) { if (xb_ld(&bar[XB_TMO])) break; if (sp > XB_SPIN_CAP) { atomicAdd(&bar[XB_TMO], 1u); break; } }
  }
  nloc = mine > 0u ? mine : 1u; nx = cnt > 0u ? cnt : 1u;
}
DI void xcd_barrier(const XcdBarrier& b) {
  asm volatile("s_waitcnt vmcnt(0)" ::: "memory");
  __syncthreads();
  if (threadIdx.x == 0) {
    unsigned* bar = b.bar;
    __builtin_amdgcn_s_waitcnt(0);
    unsigned nloc = b.st[0], nx = b.st[1];
    if (nloc == 0u) { xcd_barrier_complete(bar, b.x, nloc, nx); b.st[0] = nloc; b.st[1] = nx; }
    const unsigned old = xb_add(&bar[XB_XSUB(b.x)], 1u);
    const unsigned gen = old / nloc;
    if (old + 1u == (gen + 1u) * nloc) {
      __builtin_amdgcn_fence(__ATOMIC_RELEASE, "agent");
      asm volatile("s_waitcnt vmcnt(0)" ::: "memory");
      const unsigned og = xb_add(&bar[XB_TOP], 1u);
      const unsigned tg = og / nx;
      if (og + 1u == (tg + 1u) * nx) xb_add(&bar[XB_TOPGEN], 1u);
      else XB_SPIN(xb_ld(&bar[XB_TOPGEN]) == tg, bar);
      __builtin_amdgcn_fence(__ATOMIC_ACQUIRE, "agent");
      xb_add(&bar[XB_XGEN(b.x)], 1u);
      asm volatile("s_waitcnt vmcnt(0)" ::: "memory");
    } else {
      XB_SPIN(xb_ld(&bar[XB_XGEN(b.x)]) == gen, bar);
      __builtin_amdgcn_fence(__ATOMIC_ACQUIRE, "agent");
      asm volatile("s_waitcnt vmcnt(0)" ::: "memory");
    }
  }
  __syncthreads();
}

#define RAW_BARRIER() do { asm volatile("s_waitcnt lgkmcnt(0)" ::: "memory"); __builtin_amdgcn_s_barrier(); asm volatile("" ::: "memory"); } while (0)
template <int NJ, class Epi>
DI void gemm_tile(const u16* __restrict__ A, int lda, const u16* __restrict__ B, int ldb, int K, int m0, int n0, char* smem, Epi&& epi) {
  constexpr int BN = 64 * NJ;
  constexpr int NBI = BN / 128;
  constexpr int SA_BYTES = 256 * 64, SB_BYTES = BN * 64, STAGE = SA_BYTES + SB_BYTES;
  constexpr int NLD = 2 + NBI;
  static_assert(NLD == 4 || NLD == 3, "vmcnt immediates below assume this");
  const int tid = opq_full(), lane = tid & 63, w = tid >> 6, r = lane & 31, h = lane >> 5;
  const int wm = w >> 1, wn = w & 1;
  f32x16 acc[2][NJ];
#pragma unroll
  for (int i = 0; i < 2; ++i)
#pragma unroll
    for (int j = 0; j < NJ; ++j)
#pragma unroll
      for (int e = 0; e < 16; ++e) acc[i][j][e] = 0.f;
  const int drow = lane >> 2, dch = (lane & 3) ^ (lane >> 4);
  const u16* ga0 = A + (size_t)(m0 + (w * 2 + 0) * 16 + drow) * lda + dch * 8;
  const u16* ga1 = A + (size_t)(m0 + (w * 2 + 1) * 16 + drow) * lda + dch * 8;
  const u16* gb0 = B + (size_t)(n0 + (w * NBI + 0) * 16 + drow) * ldb + dch * 8;
  const u16* gb1 = B + (size_t)(n0 + (w * NBI + (NBI - 1)) * 16 + drow) * ldb + dch * 8;
  const int nk = K >> 5;
  const int rot = (m0 >> 8) % nk;
  auto issue = [&](int j, int buf) {
    int jj = j < nk ? j : nk - 1;
    int kk = rot + jj; kk = kk >= nk ? kk - nk : kk;
    const int k0 = kk * 32;
    char* sb_ = smem + buf * STAGE;
    __builtin_amdgcn_global_load_lds((const unsigned*)(ga0 + k0), (__attribute__((address_space(3))) unsigned*)(sb_ + (w * 2 + 0) * 1024), 16, 0, 0);
    __builtin_amdgcn_global_load_lds((const unsigned*)(ga1 + k0), (__attribute__((address_space(3))) unsigned*)(sb_ + (w * 2 + 1) * 1024), 16, 0, 0);
    __builtin_amdgcn_global_load_lds((const unsigned*)(gb0 + k0), (__attribute__((address_space(3))) unsigned*)(sb_ + SA_BYTES + (w * NBI + 0) * 1024), 16, 0, 0);
    if (NBI == 2)
      __builtin_amdgcn_global_load_lds((const unsigned*)(gb1 + k0), (__attribute__((address_space(3))) unsigned*)(sb_ + SA_BYTES + (w * NBI + 1) * 1024), 16, 0, 0);
  };
  const unsigned sw = (unsigned)((r >> 2) & 3);
  const unsigned sbase = (unsigned)(size_t)smem;
  const unsigned so0 = ((0u * 2u + (unsigned)h) ^ sw) * 16u, so1 = ((1u * 2u + (unsigned)h) ^ sw) * 16u;
  const unsigned rowA = (unsigned)(wm * 64 + r) * 64u, rowB = (unsigned)SA_BYTES + (unsigned)(wn * 32 * NJ + r) * 64u;
#define LDS_RD(dst, addr, OFF) asm volatile("ds_read_b128 %0, %1 offset:%2" : "=v"(dst) : "v"(addr), "n"(OFF) : "memory")
  __syncthreads();
  issue(0, 0); issue(1, 1); issue(2, 2);
  for (int kt = 0; kt < nk; ++kt) {
    if (NLD == 4) asm volatile("s_waitcnt vmcnt(8)" ::: "memory"); else asm volatile("s_waitcnt vmcnt(6)" ::: "memory");
    RAW_BARRIER();
    issue(kt + 3, (kt + 3) & 3);
    const unsigned st = sbase + (unsigned)(kt & 3) * (unsigned)STAGE;
    const unsigned pa0 = st + rowA + so0, pa1 = st + rowA + so1, pb0 = st + rowB + so0, pb1 = st + rowB + so1;
    bf16x8 a00, a10, a01, a11, b0[NJ], b1[NJ];
    LDS_RD(a00, pa0, 0); LDS_RD(a10, pa0, 2048);
    LDS_RD(b0[0], pb0, 0); LDS_RD(b0[1], pb0, 2048);
    if (NJ == 4) { LDS_RD(b0[NJ - 2], pb0, 4096); LDS_RD(b0[NJ - 1], pb0, 6144); }
    LDS_RD(a01, pa1, 0); LDS_RD(a11, pa1, 2048);
    LDS_RD(b1[0], pb1, 0); LDS_RD(b1[1], pb1, 2048);
    if (NJ == 4) { LDS_RD(b1[NJ - 2], pb1, 4096); LDS_RD(b1[NJ - 1], pb1, 6144); }
    if (NJ == 4) asm volatile("s_waitcnt lgkmcnt(6)" : "+v"(a00), "+v"(a10), "+v"(b0[0]), "+v"(b0[1]), "+v"(b0[NJ - 2]), "+v"(b0[NJ - 1]) :: "memory");
    else asm volatile("s_waitcnt lgkmcnt(4)" : "+v"(a00), "+v"(a10), "+v"(b0[0]), "+v"(b0[1]) :: "memory");
#pragma unroll
    for (int j = 0; j < NJ; ++j) {
      acc[0][j] = MFMA32(a00, b0[j], acc[0][j]);
      acc[1][j] = MFMA32(a10, b0[j], acc[1][j]);
    }
    if (NJ == 4) asm volatile("s_waitcnt lgkmcnt(0)" : "+v"(a01), "+v"(a11), "+v"(b1[0]), "+v"(b1[1]), "+v"(b1[NJ - 2]), "+v"(b1[NJ - 1]) :: "memory");
    else asm volatile("s_waitcnt lgkmcnt(0)" : "+v"(a01), "+v"(a11), "+v"(b1[0]), "+v"(b1[1]) :: "memory");
#pragma unroll
    for (int j = 0; j < NJ; ++j) {
      acc[0][j] = MFMA32(a01, b1[j], acc[0][j]);
      acc[1][j] = MFMA32(a11, b1[j], acc[1][j]);
    }
  }
  asm volatile("s_waitcnt vmcnt(0)" ::: "memory");
#pragma unroll
  for (int i = 0; i < 2; ++i)
#pragma unroll
    for (int g = 0; g < 4; ++g) {
      int m = m0 + wm * 64 + i * 32 + 8 * g + 4 * h;
#pragma unroll
      for (int jp = 0; jp < NJ / 2; ++jp) {
        float4 vA = make_float4(acc[i][2 * jp][4 * g], acc[i][2 * jp][4 * g + 1], acc[i][2 * jp][4 * g + 2], acc[i][2 * jp][4 * g + 3]);
        float4 vB = make_float4(acc[i][2 * jp + 1][4 * g], acc[i][2 * jp + 1][4 * g + 1], acc[i][2 * jp + 1][4 * g + 2], acc[i][2 * jp + 1][4 * g + 3]);
        epi(m, n0 + wn * 32 * NJ + jp * 64 + r, vA, vB);
      }
    }
}

DI float f4get(const float4& v, int e) { return e == 0 ? v.x : e == 1 ? v.y : e == 2 ? v.z : v.w; }

struct ConvP { const float* src; u16* dst; int N, ldd, row0, mode, k0, n0; };
DI ConvP conv_params(CP P, int t) {
  const float* src = nullptr; u16* dst = nullptr; int K = 0, N = 64, ldd = 0, row0 = 0, mode = 0; bool found = false;
#define TRY(SRC, KK, NN, DST, LDD, ROW0, MODE)                                   \
  if (!found) { int nt_ = ((KK) / 64) * ((NN) / 64);                              \
    if (t < nt_) { src = (SRC); K = (KK); N = (NN); dst = (DST); ldd = (LDD); row0 = (ROW0); mode = (MODE); found = true; } else t -= nt_; }
#pragma unroll
  for (int i = 0; i < 4; ++i) {
    TRY(P.in[13] + (size_t)i * DM * DFF, DM, DFF, P.Wgu + (size_t)i * 5632 * DM, DM, 0, 1)
    TRY(P.in[14] + (size_t)i * DM * DFF, DM, DFF, P.Wgu + (size_t)i * 5632 * DM, DM, 0, 2)
    TRY(P.in[15] + (size_t)i * DFF * DM, DFF, DM, P.Wd + (size_t)i * DM * DFF, DFF, 0, 0)
  }
#pragma unroll
  for (int j = 0; j < 2; ++j) {
    TRY(P.in[17] + (size_t)j * DM * 512, DM, 512, P.Wdqkv + (size_t)j * 1024 * DM, DM, 0, 0)
    TRY(P.in[20] + (size_t)j * DM * 320, DM, 320, P.Wdqkv + (size_t)j * 1024 * DM, DM, 512, 0)
    TRY(P.in[19] + (size_t)j * 512 * 1536, 512, 1536, P.Wuq + (size_t)j * 1536 * 512, 512, 0, 0)
    TRY(P.in[22] + (size_t)j * 256 * 1024, 256, 1024, P.Wukv + (size_t)j * 2048 * 256, 256, 0, 0)
    TRY(P.in[23] + (size_t)j * 256 * 1024, 256, 1024, P.Wukv + (size_t)j * 2048 * 256, 256, 1024, 0)
    TRY(P.in[24] + (size_t)j * DM * DM, DM, DM, P.Wmo + (size_t)j * DM * DM, DM, 0, 0)
  }
  TRY(P.in[25], DM, DM, P.Wh, DM, 0, 0)
  TRY(P.in[26], DM, DM, P.Wh, DM, 1024, 0)
  TRY(P.in[26] + (size_t)DM * DM, DM, DM, P.Wh, DM, 2048, 0)
  TRY(P.in[27], DM, DM, P.Wh, DM, 3072, 0)
  TRY(P.in[28], DM, DM, P.Wh, DM, 4096, 0)
  TRY(P.in[30], DM, DM, P.Who, DM, 0, 0)
  TRY(P.in[32], DM, DM, P.Wsqkv, DM, 0, 0)
  TRY(P.in[33], DM, 256, P.Wsqkv, DM, 1024, 0)
  TRY(P.in[34], DM, 256, P.Wsqkv, DM, 1280, 0)
  TRY(P.in[35], DM, DM, P.Wso, DM, 0, 0)
#undef TRY
  const int ntn = N / 64;
  const int tk = t / ntn, tn = t - tk * ntn;
  ConvP c; c.src = src; c.dst = dst; c.N = N; c.ldd = ldd; c.row0 = row0; c.mode = mode; c.k0 = tk * 64; c.n0 = tn * 64;
  return c;
}
#define CONV_LOAD(c, v0, v1, v2, v3, tid) do {                                                                         \
    const float* sp_ = (c).src + (size_t)((c).k0 + ((tid) >> 4)) * (c).N + (c).n0 + ((tid) & 15) * 4;                   \
    v0 = *(const f32x4*)(sp_); v1 = *(const f32x4*)(sp_ + (size_t)16 * (c).N);                                          \
    v2 = *(const f32x4*)(sp_ + (size_t)32 * (c).N); v3 = *(const f32x4*)(sp_ + (size_t)48 * (c).N); } while (0)
DI void conv_store(const ConvP& c, f32x4 v0, f32x4 v1, f32x4 v2, f32x4 v3, int tid, char* smem) {
  u16* t = (u16*)smem;
  HBAR();
  const int k = tid >> 4, n4 = (tid & 15) * 4;
#pragma unroll
  for (int j = 0; j < 4; ++j) {
    t[(n4 + j) * 72 + k] = f2bf(v0[j]);
    t[(n4 + j) * 72 + k + 16] = f2bf(v1[j]);
    t[(n4 + j) * 72 + k + 32] = f2bf(v2[j]);
    t[(n4 + j) * 72 + k + 48] = f2bf(v3[j]);
  }
  HBAR();
  const int n = tid >> 2, q = tid & 3;
  const int nn = c.n0 + n;
  const int row = c.mode == 0 ? c.row0 + nn : ((nn >> 5) * 64 + (c.mode == 2 ? 32 : 0) + (nn & 31));
  uint4 a = *(const uint4*)(t + n * 72 + q * 16);
  uint4 b = *(const uint4*)(t + n * 72 + q * 16 + 8);
  u16* d = c.dst + (size_t)row * c.ldd + c.k0 + q * 16;
  *(uint4*)d = a;
  *(uint4*)(d + 8) = b;
}
#define N_CONV_TILES 12192

DI void adaln_item(CP P, int it, char* smem) {
  const int i = it / 96, cb = it - i * 96;
  float* s = (float*)smem;
  const int tid = (opq_full() & 255);
  HBAR();
  for (int e = tid; e < 3072; e += 256) {
    int rr = e >> 10, k = e & 1023;
    float c = rr == 0 ? P.in[8][k] : P.in[7][(rr - 1) * 1024 + k];
    s[e] = silu_f(c);
  }
  HBAR();
  const int kg = tid >> 4, c4 = (tid & 15) * 4;
  const float* wp = P.in[9] + ((size_t)i * 1024 + kg * 64) * 6144 + cb * 64 + c4;
  f32x4 a0 = {0.f, 0.f, 0.f, 0.f}, a1 = a0, a2 = a0;
#pragma unroll 16
  for (int k = 0; k < 64; ++k) {
    f32x4 wv = *(const f32x4*)(wp + (size_t)k * 6144);
    a0 += s[kg * 64 + k] * wv;
    a1 += s[1024 + kg * 64 + k] * wv;
    a2 += s[2048 + kg * 64 + k] * wv;
  }
  float* red = s + 3072;
  *(f32x4*)(red + (kg * 3 + 0) * 64 + c4) = a0;
  *(f32x4*)(red + (kg * 3 + 1) * 64 + c4) = a1;
  *(f32x4*)(red + (kg * 3 + 2) * 64 + c4) = a2;
  HBAR();
  if (tid < 192) {
    const int rr = tid >> 6, c2 = tid & 63;
    float sum = 0.f;
#pragma unroll
    for (int g = 0; g < 16; ++g) sum += red[(g * 3 + rr) * 64 + c2];
    const int nn = cb * 64 + c2;
    P.mod[(size_t)(i * 3 + rr) * 6144 + nn] = sum + P.in[10][i * 6144 + nn];
  }
}

DI void misc_item(CP P, int it) {
  const int tid = (opq_full() & 255);
  for (int p = 0; p < 8; ++p) {
    int e = it * 2048 + p * 256 + tid;
    if (e < 262144) {
      int c = e & 255, l = (e >> 8) & 255, j = (e >> 16) & 1, b = e >> 17;
      P.CKVk[((size_t)j * KROWS + MP + b * 2304 + l) * 256 + c] = f2bf(P.in[2][e]);
    } else if (e < 262144 + 65536) {
      int e2 = e - 262144;
      int c = e2 & 63, l = (e2 >> 6) & 255, j = (e2 >> 14) & 1, b = e2 >> 15;
      P.KRk[((size_t)j * KROWS + MP + b * 2304 + l) * 64 + c] = f2bf(P.in[3][e2]);
    } else if (e < 262144 + 65536 + 131072) {
      int e2 = e - 327680;
      int c = e2 & 255, l = (e2 >> 8) & 255, b = e2 >> 16;
      P.KSk[((size_t)MP + b * 2304 + l) * 256 + c] = f2bf(P.in[5][e2]);
    } else if (e < 589824) {
      int e2 = e - 458752;
      int d = e2 & 63, kvh = (e2 >> 6) & 3, l = (e2 >> 8) & 255, b = e2 >> 16;
      P.VtS2[((size_t)(b * 4 + kvh) * 64 + d) * 2304 + l] = f2bf(P.in[6][e2]);
    }
  }
}
#define N_MISC_ITEMS 288

DI void phase0(CP P, char* smem) {
  const int tid = (opq_full() & 255);
  const int vb = VBLK, vg = VGRID;
  {
    int t = vb;
    ConvP cur; f32x4 v0, v1, v2, v3;
    if (t < N_CONV_TILES) { cur = conv_params(P, t); CONV_LOAD(cur, v0, v1, v2, v3, tid); }
    for (; t < N_CONV_TILES; t += vg) {
      const int tn = t + vg;
      ConvP nx = cur; f32x4 w0 = v0, w1 = v1, w2 = v2, w3 = v3;
      if (tn < N_CONV_TILES) { nx = conv_params(P, tn); CONV_LOAD(nx, w0, w1, w2, w3, tid); }
      conv_store(cur, v0, v1, v2, v3, tid, smem);
      cur = nx; v0 = w0; v1 = w1; v2 = w2; v3 = w3;
    }
  }
  for (int it = vg - 1 - vb; it < 384; it += vg) adaln_item(P, it, smem);
  for (int it = vb; it < N_MISC_ITEMS + 2; it += vg) {
    if (it < N_MISC_ITEMS) { misc_item(P, it); continue; }
    if (it == N_MISC_ITEMS) {
      for (int e = tid; e < 2048; e += 256) {
        int d = e >> 10, kd = e & 1023;
        const float* lg = P.in[31] + (size_t)d * 4 * 1024 + kd;
        float l0 = lg[0], l1 = lg[1024], l2 = lg[2048], l3 = lg[3072];
        float mx = fmaxf(fmaxf(l0, l1), fmaxf(l2, l3));
        float e0 = __expf(l0 - mx), e1 = __expf(l1 - mx), e2 = __expf(l2 - mx), e3 = __expf(l3 - mx);
        P.lb[e] = e1 / (e0 + e1 + e2 + e3);
      }
    } else {
      for (int e = tid; e < 2 * 192 * 1024 / 8; e += 256) {
        int j = e / (192 * 128), rem = e - j * 192 * 128;
        *(uint4*)(P.Wdqkv + (size_t)j * 1024 * DM + (size_t)832 * DM + (size_t)rem * 8) = make_uint4(0, 0, 0, 0);
      }
    }
  }
}

DI float wave_sum(float v) {
#pragma unroll
  for (int o = 32; o >= 1; o >>= 1) v += __shfl_xor(v, o);
  return v;
}

DI void normmod_phase(CP P, int layer, int which  , const float* gain, u16* H, bool first = false) {
  const int tid_ = (opq_full() & 255); const int lane = tid_ & 63, w = tid_ >> 6;
  const int stride = VGRID * 4;
  int m = VBLK * 4 + w;
  f32x4 g[4], v[4];
#pragma unroll
  for (int i = 0; i < 4; ++i) g[i] = *(const f32x4*)(gain + (i * 64 + lane) * 4);
  if (m < MT) {
    if (first) {
      const float* x = m < MP ? P.in[0] + (size_t)m * DM : P.in[1] + (size_t)(m - MP) * DM;
#pragma unroll
      for (int i = 0; i < 4; ++i) v[i] = *(const f32x4*)(x + (i * 64 + lane) * 4);
    } else {
#pragma unroll
      for (int i = 0; i < 4; ++i) v[i] = ldx4(P.X + (size_t)m * DM + (i * 64 + lane) * 4);
    }
  }
  for (; m < MT; m += stride) {
    const int mn = m + stride;
    f32x4 nv[4];
#pragma unroll
    for (int i = 0; i < 4; ++i) nv[i] = v[i];
    if (mn < MT) {
      if (first) {
        const float* xn = mn < MP ? P.in[0] + (size_t)mn * DM : P.in[1] + (size_t)(mn - MP) * DM;
#pragma unroll
        for (int i = 0; i < 4; ++i) nv[i] = *(const f32x4*)(xn + (i * 64 + lane) * 4);
      } else {
#pragma unroll
        for (int i = 0; i < 4; ++i) nv[i] = ldx4(P.X + (size_t)mn * DM + (i * 64 + lane) * 4);
      }
    }
    const float* md = P.mod + (size_t)(layer * 3 + grp_of(m)) * 6144 + which * 3072;
    f32x4 sh[4], sc[4];
#pragma unroll
    for (int i = 0; i < 4; ++i) { sh[i] = *(const f32x4*)(md + (i * 64 + lane) * 4); sc[i] = *(const f32x4*)(md + 1024 + (i * 64 + lane) * 4); }
    float ss = 0.f;
#pragma unroll
    for (int i = 0; i < 4; ++i) ss += v[i].x * v[i].x + v[i].y * v[i].y + v[i].z * v[i].z + v[i].w * v[i].w;
    if (first) {
#pragma unroll
      for (int i = 0; i < 4; ++i) *(uint2*)(P.X + (size_t)m * DM + (i * 64 + lane) * 4) = make_uint2(pack2(v[i].x, v[i].y), pack2(v[i].z, v[i].w));
    }
    ss = wave_sum(ss);
    const float rstd = rsqrtf(ss * (1.f / DM) + 1e-6f);
#pragma unroll
    for (int i = 0; i < 4; ++i) {
      const int c = (i * 64 + lane) * 4;
      f32x4 o = v[i] * rstd * g[i] * (1.f + sc[i]) + sh[i];
      *(uint2*)(H + (size_t)m * DM + c) = make_uint2(pack2(o.x, o.y), pack2(o.z, o.w));
    }
#pragma unroll
    for (int i = 0; i < 4; ++i) v[i] = nv[i];
  }
}

DI void final_norm_phase(CP P) {
  const int tid_ = (opq_full() & 255); const int lane = tid_ & 63, w = tid_ >> 6;
  for (int m = VBLK * 4 + w; m < MT; m += VGRID * 4) {
    const u16* x = P.X + (size_t)m * DM;
    f32x4 v[4]; float ss = 0.f;
#pragma unroll
    for (int i = 0; i < 4; ++i) { v[i] = ldx4(x + (i * 64 + lane) * 4); ss += v[i].x * v[i].x + v[i].y * v[i].y + v[i].z * v[i].z + v[i].w * v[i].w; }
    ss = wave_sum(ss);
    float rstd = rsqrtf(ss * (1.f / DM) + 1e-6f);
#pragma unroll
    for (int i = 0; i < 4; ++i) {
      int c = (i * 64 + lane) * 4;
      float4 g = *(const float4*)(P.in[16] + c);
      *(float4*)(P.out + (size_t)m * DM + c) = make_float4(v[i].x * rstd * g.x, v[i].y * rstd * g.y, v[i].z * rstd * g.z, v[i].w * rstd * g.w);
    }
  }
}

DI void mla_rownorm_phase(CP P, int j, const float* RAW, u16* QN) {
  const int tid_ = (opq_full() & 255); const int lane = tid_ & 63, w = tid_ >> 6;
  const float* qg = P.in[18] + j * 512;
  const float* kg = P.in[21] + j * 256;
  u16* CK = P.CKVk + (size_t)j * KROWS * 256;
  u16* KR = P.KRk + (size_t)j * KROWS * 64;
  for (int m = VBLK * 4 + w; m < MT; m += VGRID * 4) {
    const float* x = RAW + (size_t)m * 832;
    float4 q0 = *(const float4*)(x + lane * 4), q1 = *(const float4*)(x + 256 + lane * 4);
    float4 kv = *(const float4*)(x + 512 + lane * 4);
    float kr = x[768 + lane];
    float sq = q0.x * q0.x + q0.y * q0.y + q0.z * q0.z + q0.w * q0.w + q1.x * q1.x + q1.y * q1.y + q1.z * q1.z + q1.w * q1.w;
    float sk = kv.x * kv.x + kv.y * kv.y + kv.z * kv.z + kv.w * kv.w;
    sq = wave_sum(sq); sk = wave_sum(sk);
    float rq = rsqrtf(sq * (1.f / 512.f) + 1e-6f), rk = rsqrtf(sk * (1.f / 256.f) + 1e-6f);
    float4 g0 = *(const float4*)(qg + lane * 4), g1 = *(const float4*)(qg + 256 + lane * 4), g2 = *(const float4*)(kg + lane * 4);
    *(uint2*)(QN + (size_t)m * 512 + lane * 4) = make_uint2(pack2(q0.x * rq * g0.x, q0.y * rq * g0.y), pack2(q0.z * rq * g0.z, q0.w * rq * g0.w));
    *(uint2*)(QN + (size_t)m * 512 + 256 + lane * 4) = make_uint2(pack2(q1.x * rq * g1.x, q1.y * rq * g1.y), pack2(q1.z * rq * g1.z, q1.w * rq * g1.w));
    float4 c = make_float4(kv.x * rk * g2.x, kv.y * rk * g2.y, kv.z * rk * g2.z, kv.w * rk * g2.w);
    const int kr_row = keyrow_of(m);
    *(uint2*)(CK + (size_t)kr_row * 256 + lane * 4) = make_uint2(pack2(c.x, c.y), pack2(c.z, c.w));
    float partner = __shfl_xor(kr, 16);
    if (m < MP) {
      int b = m >> 8, s = m & 255;
      *(float4*)(P.out + OUT_CKV + ((size_t)(b * 2 + j) * 256 + s) * 256 + lane * 4) = c;
      P.out[OUT_KR + ((size_t)(b * 2 + j) * 256 + s) * 64 + lane] = kr;
      KR[(size_t)kr_row * 64 + lane] = f2bf(kr);
    } else {
      int s = (m - MP) & 2047;
      KR[(size_t)kr_row * 64 + lane] = f2bf(rope1(kr, partner, lane, s));
    }
  }
}

DI void hgrn_post_phase(CP P, const u16* Of, const u16* Ob, const u16* Gh, u16* A2) {
  const int tid_ = (opq_full() & 255); const int lane = tid_ & 63, w = tid_ >> 6;
  for (int m = VBLK * 4 + w; m < MT; m += VGRID * 4) {
#pragma unroll
    for (int i = 0; i < 4; ++i) {
      int c = (i * 64 + lane) * 4;
      uint2 a = *(const uint2*)(Of + (size_t)m * DM + c), b = *(const uint2*)(Ob + (size_t)m * DM + c), g = *(const uint2*)(Gh + (size_t)m * DM + c);
      float o0 = bf2f((u16)(a.x & 0xffff)) + bf2f((u16)(b.x & 0xffff));
      float o1 = bf2f((u16)(a.x >> 16)) + bf2f((u16)(b.x >> 16));
      float o2 = bf2f((u16)(a.y & 0xffff)) + bf2f((u16)(b.y & 0xffff));
      float o3 = bf2f((u16)(a.y >> 16)) + bf2f((u16)(b.y >> 16));
      float ss = o0 * o0 + o1 * o1 + o2 * o2 + o3 * o3;
#pragma unroll
      for (int o = 16; o >= 1; o >>= 1) ss += __shfl_xor(ss, o);
      float rstd = rsqrtf(ss * (1.f / 128.f) + 1e-6f);
      float4 gn = *(const float4*)(P.in[29] + (c & 127));
      o0 = o0 * rstd * gn.x * bf2f((u16)(g.x & 0xffff));
      o1 = o1 * rstd * gn.y * bf2f((u16)(g.x >> 16));
      o2 = o2 * rstd * gn.z * bf2f((u16)(g.y & 0xffff));
      o3 = o3 * rstd * gn.w * bf2f((u16)(g.y >> 16));
      *(uint2*)(A2 + (size_t)m * DM + c) = make_uint2(pack2(o0, o1), pack2(o2, o3));
    }
  }
}

template <int DKN, int DKR, int DV>
DI void attn_item(const u16* __restrict__ Q, int ldq, int qoff, int m0,
                  const u16* __restrict__ Kn, int ldk, int koff, const u16* __restrict__ Kr, int kbase,
                  const u16* __restrict__ Vt, int ldv,
                  int e1, int lo2, int hi2, bool win, int t0, float m_init, float l_init,
                  u16* __restrict__ O, int ldo, int ooff, char* smem, bool split = false) {
  constexpr int DK = DKN + DKR;
  constexpr int KST = DK * 2 + 16;
  constexpr int KBYTES = 32 * KST;
  constexpr int VBYTES = DV * 80;
  constexpr int STAGE = KBYTES + VBYTES;
  constexpr int KCH = DK / 8;
  constexpr int NKL = (32 * KCH) / 256;
  constexpr int NVL = (DV * 4) / 256;
  const int tfull = opq_full();
  const int tid = tfull & 255, vh = tfull >> 8, lane = tid & 63, w = tid >> 6, r = lane & 31, h = lane >> 5;

  bf16x8 qf[DK / 16];
  {
    const u16* qp = Q + (size_t)(m0 + w * 32 + r) * ldq + qoff + h * 8;
#pragma unroll
    for (int ks = 0; ks < DK / 16; ++ks) qf[ks] = *(const bf16x8*)(qp + ks * 16);
  }
  f32x16 o[DV / 32];
#pragma unroll
  for (int d = 0; d < DV / 32; ++d)
#pragma unroll
    for (int e = 0; e < 16; ++e) o[d][e] = 0.f;
  float mrun = m_init, lrun = (h == 0) ? l_init : 0.f;

  const int n1 = e1 >> 5;
  const int nsteps = n1 + ((hi2 - lo2) >> 5);
  const int sbeg = split ? vh * (nsteps >> 1) : 0;
  const int send = split ? sbeg + (nsteps >> 1) : nsteps;
  u32x4 rk[NKL], rv[NVL];
  auto gload = [&](int st) {
    const int kk = st < n1 ? st * 32 : lo2 + (st - n1) * 32;
#pragma unroll
    for (int i = 0; i < NKL; ++i) {
      int c = tid + 256 * i;
      int row = c / KCH, cc = c - row * KCH;
      size_t kr_ = (size_t)(kbase + kk + row);
      const u16* src = (cc < DKN / 8) ? (Kn + kr_ * ldk + koff + cc * 8) : (Kr + kr_ * 64 + (cc - DKN / 8) * 8);
      rk[i] = *(const u32x4*)src;
    }
#pragma unroll
    for (int i = 0; i < NVL; ++i) {
      int c = tid + 256 * i;
      int row = c >> 2, cc = c & 3;
      rv[i] = *(const u32x4*)(Vt + (size_t)row * ldv + kk + cc * 8);
    }
  };
  gload(sbeg);
  HBAR();
  for (int st = sbeg; st < send; ++st) {
    char* sk = smem + ((st - sbeg) & 1) * STAGE;
    char* sv = sk + KBYTES;
#pragma unroll
    for (int i = 0; i < NKL; ++i) {
      int c = tid + 256 * i;
      int row = c / KCH, cc = c - row * KCH;
      *(u32x4*)(sk + row * KST + cc * 16) = rk[i];
    }
#pragma unroll
    for (int i = 0; i < NVL; ++i) {
      int c = tid + 256 * i;
      int row = c >> 2, cc = c & 3;
      *(u32x4*)(sv + row * 80 + cc * 16) = rv[i];
    }
    HBAR();
    const int kk = st < n1 ? st * 32 : lo2 + (st - n1) * 32;
    if (st + 1 < send) gload(st + 1);
    f32x16 x;
#pragma unroll
    for (int e = 0; e < 16; ++e) x[e] = 0.f;
    const char* pk = sk + r * KST + h * 16;
#pragma unroll
    for (int ks = 0; ks < DK / 16; ++ks) {
      bf16x8 a = *(const bf16x8*)(pk + ks * 32);
      x = MFMA32(a, qf[ks], x);
    }
    if (win && kk >= 256) {
      const int t = t0 + w * 32 + r;
      const int sb = kk - 256;
#pragma unroll
      for (int e = 0; e < 16; ++e) {
        int dlt = t - (sb + crow(e, h));
        if (dlt > 128 || dlt < -128) x[e] = -1e30f;
      }
    }
    float mloc = x[0];
#pragma unroll
    for (int e = 1; e < 16; ++e) mloc = fmaxf(mloc, x[e]);
    mloc = fmaxf(mloc, __shfl_xor(mloc, 32));
    const float mnew = fmaxf(mrun, mloc);
    const float alpha = __builtin_amdgcn_exp2f(mrun - mnew);
    mrun = mnew;
    float psum = 0.f;
#pragma unroll
    for (int e = 0; e < 16; ++e) { x[e] = __builtin_amdgcn_exp2f(x[e] - mnew); psum += x[e]; }
    lrun = lrun * alpha + psum;
#pragma unroll
    for (int d = 0; d < DV / 32; ++d)
#pragma unroll
      for (int e = 0; e < 16; ++e) o[d][e] *= alpha;
    bf16x8 pb0 = pack8(x[0], x[1], x[2], x[3], x[4], x[5], x[6], x[7]);
    bf16x8 pb1 = pack8(x[8], x[9], x[10], x[11], x[12], x[13], x[14], x[15]);
#pragma unroll
    for (int d = 0; d < DV / 32; ++d) {
      const char* pv = sv + (d * 32 + r) * 80 + h * 8;
      s16x4 lo0 = *(const s16x4*)(pv), hi0 = *(const s16x4*)(pv + 16);
      s16x4 lo1 = *(const s16x4*)(pv + 32), hi1 = *(const s16x4*)(pv + 48);
      bf16x8 av0 = __builtin_shufflevector(lo0, hi0, 0, 1, 2, 3, 4, 5, 6, 7);
      bf16x8 av1 = __builtin_shufflevector(lo1, hi1, 0, 1, 2, 3, 4, 5, 6, 7);
      o[d] = MFMA32(av0, pb0, o[d]);
      o[d] = MFMA32(av1, pb1, o[d]);
    }
  }
  if (split) {
    float* xch = (float*)(vh ? smem : smem + HALF_LDS);
    HBAR();
    if (vh == 1) {
#pragma unroll
      for (int d = 0; d < DV / 32; ++d)
#pragma unroll
        for (int e = 0; e < 16; ++e) xch[(d * 16 + e) * 256 + tid] = o[d][e];
      xch[(DV / 2) * 256 + tid] = mrun;
      xch[(DV / 2 + 1) * 256 + tid] = lrun;
    }
    __syncthreads();
    if (vh == 0) {
      const float m1 = xch[(DV / 2) * 256 + tid], l1 = xch[(DV / 2 + 1) * 256 + tid];
      const float mnew = fmaxf(mrun, m1);
      const float a0 = __builtin_amdgcn_exp2f(mrun - mnew), a1 = __builtin_amdgcn_exp2f(m1 - mnew);
      lrun = lrun * a0 + l1 * a1;
#pragma unroll
      for (int d = 0; d < DV / 32; ++d)
#pragma unroll
        for (int e = 0; e < 16; ++e) o[d][e] = o[d][e] * a0 + xch[(d * 16 + e) * 256 + tid] * a1;
    }
    __syncthreads();
    if (vh == 1) return;
  }
  const float ltot = lrun + __shfl_xor(lrun, 32);
  const float inv = 1.f / ltot;
  u16* op = O + (size_t)(m0 + w * 32 + r) * ldo + ooff;
#pragma unroll
  for (int d = 0; d < DV / 32; ++d)
#pragma unroll
    for (int g = 0; g < 4; ++g)
      *(uint2*)(op + d * 32 + 8 * g + 4 * h) = make_uint2(pack2(o[d][4 * g] * inv, o[d][4 * g + 1] * inv), pack2(o[d][4 * g + 2] * inv, o[d][4 * g + 3] * inv));
}

DI void hgrn_item(CP P, int kind, int idx, const u16* Qh, const u16* Vh, const f16* LF, u16* Oout, float* Lbuf, float* Dbuf, char* smem) {
  const int tid = (opq_full() & 255), lane = tid & 63, w = tid >> 6, r = lane & 31, h = lane >> 5;
  int S, mb, hh, dir, bp = 0, bl = 0, seg = 0, q = 0;
  if (kind == 0) { bp = idx >> 4; hh = (idx >> 1) & 7; dir = idx & 1; S = 256; mb = bp * 256; }
  else {
    if (kind == 1) { q = idx / 7; seg = idx - q * 7; } else { q = idx >> 3; seg = idx & 7; }
    bl = q >> 4; hh = (q >> 1) & 7; dir = q & 1; S = 2048; mb = MP + bl * 2048;
  }
  const int u0 = seg * 256;
  const bool write_o = kind != 1;
  char* Qs = smem;
  char* Ks = smem + 8704;
  char* KsT = smem + 17408;
  char* VT = smem + 27648;
  float* erho = (float*)(smem + 37888);
  float* elast = erho + 128;
  float* exch = elast + 128;
  const f16* lf_base = LF + (size_t)dir * MT * DM;
  u16* Od = Oout + (size_t)dir * MT * DM;

  f32x16 st[4];
  if (kind != 2) {
#pragma unroll
    for (int t = 0; t < 4; ++t)
#pragma unroll
      for (int e = 0; e < 16; ++e) st[t][e] = 0.f;
  } else {
    const float* s0 = P.in[4] + ((size_t)((bl * 2 + dir) * 8 + hh)) * 128 * 128;
#pragma unroll
    for (int t = 0; t < 4; ++t)
#pragma unroll
      for (int e = 0; e < 16; ++e) st[t][e] = s0[(size_t)(32 * t + crow(e, h)) * 128 + 32 * w + r];
#pragma unroll 1
    for (int j = 0; j < seg; ++j) {
      const float* Lj = Lbuf + (size_t)(q * 7 + j) * 16384;
      const float* Dj = Dbuf + (size_t)(q * 7 + j) * 128;
#pragma unroll
      for (int t = 0; t < 4; ++t)
#pragma unroll
        for (int g = 0; g < 4; ++g) {
          int k = 32 * t + 8 * g + 4 * h;
          float4 dj = *(const float4*)(Dj + k);
          const float* lp = Lj + (size_t)k * 128 + 32 * w + r;
          st[t][4 * g] = dj.x * st[t][4 * g] + lp[0];
          st[t][4 * g + 1] = dj.y * st[t][4 * g + 1] + lp[128];
          st[t][4 * g + 2] = dj.z * st[t][4 * g + 2] + lp[256];
          st[t][4 * g + 3] = dj.w * st[t][4 * g + 3] + lp[384];
        }
    }
  }
  float dlog = 0.f;
  const int kd = tid & 127, th = tid >> 7;
  const int nch = 8;
  typedef _Float16 f16x2 __attribute__((ext_vector_type(2)));
  typedef unsigned short u16x2 __attribute__((ext_vector_type(2)));
  f16x2 plf[8]; u16x2 pq[8], pv[8];
#pragma unroll
  for (int t16 = 0; t16 < 16; ++t16) {
    int t = th * 16 + t16;
    int tok = dir ? (S - 1 - (u0 + t)) : (u0 + t);
    size_t gi = (size_t)(mb + tok) * DM + hh * 128 + kd;
    plf[t16 >> 1][t16 & 1] = lf_base[gi]; pq[t16 >> 1][t16 & 1] = Qh[gi]; pv[t16 >> 1][t16 & 1] = Vh[gi];
  }
  for (int c = 0; c < nch; ++c) {
    HBAR();
    float bc[16];
    float run = 0.f;
#pragma unroll
    for (int t16 = 0; t16 < 16; ++t16) {
      run += (float)plf[t16 >> 1][t16 & 1];
      bc[t16] = run;
    }
    if (th == 0) exch[kd] = run;
    HBAR();
    const float rho = exch[kd];
    if (th == 1) {
#pragma unroll
      for (int t16 = 0; t16 < 16; ++t16) bc[t16] += rho;
      elast[kd] = __expf(bc[15] - rho);
      erho[kd] = __expf(rho);
      dlog += bc[15];
    }
#pragma unroll
    for (int t16 = 0; t16 < 16; ++t16) {
      int t = th * 16 + t16;
      float q = bf2f(pq[t16 >> 1][t16 & 1]);
      float kval = 1.f - __expf((float)plf[t16 >> 1][t16 & 1]);
      float dq = bc[t16] - rho;
      u16 qb = f2bf(q * __expf(dq));
      u16 kb = f2bf(kval * __expf(-dq));
      *(u16*)(Qs + t * 272 + kd * 2) = qb;
      *(u16*)(Ks + t * 272 + kd * 2) = kb;
      *(u16*)(KsT + kd * 80 + t * 2) = kb;
      *(u16*)(VT + kd * 80 + t * 2) = pv[t16 >> 1][t16 & 1];
    }
    if (c + 1 < nch) {
#pragma unroll
      for (int t16 = 0; t16 < 16; ++t16) {
        int t = th * 16 + t16;
        int tok = dir ? (S - 1 - (u0 + (c + 1) * 32 + t)) : (u0 + (c + 1) * 32 + t);
        size_t gi = (size_t)(mb + tok) * DM + hh * 128 + kd;
        plf[t16 >> 1][t16 & 1] = lf_base[gi]; pq[t16 >> 1][t16 & 1] = Qh[gi]; pv[t16 >> 1][t16 & 1] = Vh[gi];
      }
    }
    HBAR();
#pragma unroll
    for (int t = 0; t < 4; ++t)
#pragma unroll
      for (int g = 0; g < 4; ++g) {
        float4 er = *(const float4*)(erho + 32 * t + 8 * g + 4 * h);
        st[t][4 * g] *= er.x; st[t][4 * g + 1] *= er.y; st[t][4 * g + 2] *= er.z; st[t][4 * g + 3] *= er.w;
      }
    if (write_o) {
      f32x16 x;
#pragma unroll
      for (int e = 0; e < 16; ++e) x[e] = 0.f;
#pragma unroll
      for (int ks = 0; ks < 8; ++ks) {
        bf16x8 a = *(const bf16x8*)(Ks + r * 272 + ks * 32 + h * 16);
        bf16x8 b = *(const bf16x8*)(Qs + r * 272 + ks * 32 + h * 16);
        x = MFMA32(a, b, x);
      }
#pragma unroll
      for (int e = 0; e < 16; ++e) if (crow(e, h) > r) x[e] = 0.f;
      f32x16 oacc;
#pragma unroll
      for (int e = 0; e < 16; ++e) oacc[e] = 0.f;
#pragma unroll
      for (int t = 0; t < 4; ++t) {
        bf16x8 sb0 = pack8(st[t][0], st[t][1], st[t][2], st[t][3], st[t][4], st[t][5], st[t][6], st[t][7]);
        bf16x8 sb1 = pack8(st[t][8], st[t][9], st[t][10], st[t][11], st[t][12], st[t][13], st[t][14], st[t][15]);
        const char* pq = Qs + r * 272 + (32 * t + 4 * h) * 2;
        s16x4 lo0 = *(const s16x4*)(pq), hi0 = *(const s16x4*)(pq + 16);
        s16x4 lo1 = *(const s16x4*)(pq + 32), hi1 = *(const s16x4*)(pq + 48);
        bf16x8 qa0 = __builtin_shufflevector(lo0, hi0, 0, 1, 2, 3, 4, 5, 6, 7);
        bf16x8 qa1 = __builtin_shufflevector(lo1, hi1, 0, 1, 2, 3, 4, 5, 6, 7);
        oacc = MFMA32(qa0, sb0, oacc);
        oacc = MFMA32(qa1, sb1, oacc);
      }
      {
        bf16x8 xa0 = pack8(x[0], x[1], x[2], x[3], x[4], x[5], x[6], x[7]);
        bf16x8 xa1 = pack8(x[8], x[9], x[10], x[11], x[12], x[13], x[14], x[15]);
        const char* pv = VT + (32 * w + r) * 80 + h * 8;
        s16x4 lo0 = *(const s16x4*)(pv), hi0 = *(const s16x4*)(pv + 16);
        s16x4 lo1 = *(const s16x4*)(pv + 32), hi1 = *(const s16x4*)(pv + 48);
        bf16x8 vb0 = __builtin_shufflevector(lo0, hi0, 0, 1, 2, 3, 4, 5, 6, 7);
        bf16x8 vb1 = __builtin_shufflevector(lo1, hi1, 0, 1, 2, 3, 4, 5, 6, 7);
        oacc = MFMA32(xa0, vb0, oacc);
        oacc = MFMA32(xa1, vb1, oacc);
      }
#pragma unroll
      for (int e = 0; e < 16; ++e) {
        int t = crow(e, h);
        int tok = dir ? (S - 1 - (u0 + c * 32 + t)) : (u0 + c * 32 + t);
        Od[(size_t)(mb + tok) * DM + hh * 128 + 32 * w + r] = f2bf(oacc[e]);
      }
    }
    {
      const char* pv = VT + (32 * w + r) * 80 + h * 16;
      bf16x8 vn0 = *(const bf16x8*)(pv), vn1 = *(const bf16x8*)(pv + 32);
#pragma unroll
      for (int t = 0; t < 4; ++t) {
        const char* pk = KsT + (32 * t + r) * 80 + h * 16;
        bf16x8 ka0 = *(const bf16x8*)(pk), ka1 = *(const bf16x8*)(pk + 32);
        st[t] = MFMA32(ka0, vn0, st[t]);
        st[t] = MFMA32(ka1, vn1, st[t]);
#pragma unroll
        for (int g = 0; g < 4; ++g) {
          float4 el = *(const float4*)(elast + 32 * t + 8 * g + 4 * h);
          st[t][4 * g] *= el.x; st[t][4 * g + 1] *= el.y; st[t][4 * g + 2] *= el.z; st[t][4 * g + 3] *= el.w;
        }
      }
    }
  }
  if (kind == 0) {
    float* so = P.out + OUT_HG + ((size_t)((bp * 2 + dir) * 8 + hh)) * 128 * 128;
#pragma unroll
    for (int t = 0; t < 4; ++t)
#pragma unroll
      for (int e = 0; e < 16; ++e) so[(size_t)(32 * t + crow(e, h)) * 128 + 32 * w + r] = st[t][e];
  } else if (kind == 1) {
    float* so = Lbuf + (size_t)idx * 16384;
#pragma unroll
    for (int t = 0; t < 4; ++t)
#pragma unroll
      for (int e = 0; e < 16; ++e) so[(size_t)(32 * t + crow(e, h)) * 128 + 32 * w + r] = st[t][e];
    if (th == 1) Dbuf[(size_t)idx * 128 + kd] = __expf(dlog);
  }
}

DI void gemm_residual_phase(CP P, const u16* A, int K, const u16* Bt, int layer, int which  , char* smem) {
  const int tiles = (MT / 256) * (DM / 256);
  for (int t = blockIdx.x; t < tiles; t += gridDim.x) {
    int tm = t % (MT / 256), tn = t / (MT / 256);
    gemm_tile<4>(A, K, Bt, K, K, tm * 256, tn * 256, smem, [&](int m, int n, float4 vA, float4 vB) {
      const float* gate = P.mod + (size_t)(layer * 3 + grp_of(m)) * 6144 + which * 1024;
      float gA = gate[n], gB = gate[n + 32];
#pragma unroll
      for (int e = 0; e < 4; ++e) {
        u16* xp = P.X + (size_t)(m + e) * DM + n;
        xp[0] = f2bf(bf2f(xp[0]) + gA * f4get(vA, e));
        xp[32] = f2bf(bf2f(xp[32]) + gB * f4get(vB, e));
      }
    });
  }
}

DI void ffn_block(CP P, const XcdBarrier& xb, int layer, char* smem) {
  u16* H = (u16*)P.arena;
  u16* ACT = (u16*)(P.arena + (size_t)24 * 1048576);
  normmod_phase(P, layer, 1, P.in[12] + layer * DM, H);
  xcd_barrier(xb);
  {
    const u16* Bt = P.Wgu + (size_t)layer * 5632 * DM;
    auto epi_gu = [&](int m, int n, float4 vA, float4 vB) {
      int ff = (n >> 6) * 32 + (n & 31);
#pragma unroll
      for (int e = 0; e < 4; ++e) ACT[(size_t)(m + e) * DFF + ff] = f2bf(silu_f(f4get(vA, e)) * f4get(vB, e));
    };
    for (int t = blockIdx.x; t < 1024; t += gridDim.x) {
      int tm = t % (MT / 256), tn = t / (MT / 256);
      gemm_tile<4>(H, DM, Bt, DM, DM, tm * 256, tn * 256, smem, epi_gu);
    }
    for (int u = blockIdx.x; u < 64; u += gridDim.x) {
      int ft = 1024 + (u >> 1);
      int tm = ft % (MT / 256), tn = ft / (MT / 256);
      gemm_tile<2>(H, DM, Bt, DM, DM, tm * 256, tn * 256 + (u & 1) * 128, smem, epi_gu);
    }
  }
  xcd_barrier(xb);
  gemm_residual_phase(P, ACT, DFF, P.Wd + (size_t)layer * DM * DFF, layer, 5, smem);
  xcd_barrier(xb);
}

DI void store_vt4(u16* p, float4 v) { *(uint2*)p = make_uint2(pack2(v.x, v.y), pack2(v.z, v.w)); }

DI void mla_layer(CP P, const XcdBarrier& xb, int layer, int j, char* smem) {
  const size_t MiB = 1048576;
  u16* H = (u16*)P.arena;
  float* RAW = (float*)(P.arena + 24 * MiB);
  u16* QN = (u16*)(P.arena + 63 * MiB);
  u16* Q = (u16*)(P.arena + 75 * MiB);
  u16* Kn = (u16*)(P.arena + 111 * MiB);
  u16* VtP = (u16*)(P.arena + 136 * MiB);
  u16* VtS = (u16*)(P.arena + 152 * MiB);
  u16* O = (u16*)(P.arena + 161 * MiB);
  u16* CK = P.CKVk + (size_t)j * KROWS * 256;
  u16* KR = P.KRk + (size_t)j * KROWS * 64;
  normmod_phase(P, layer, 0, P.in[11] + layer * DM, H, layer == 0);
  xcd_barrier(xb);
  {
    const u16* Bt = P.Wdqkv + (size_t)j * 1024 * DM;
    const int tiles = (MT / 256) * 4;
    for (int t = blockIdx.x; t < tiles; t += gridDim.x) {
      int tm = t % (MT / 256), tn = t / (MT / 256);
      gemm_tile<4>(H, DM, Bt, DM, DM, tm * 256, tn * 256, smem, [&](int m, int n, float4 vA, float4 vB) {
#pragma unroll
        for (int e = 0; e < 4; ++e) {
          if (n < 832) RAW[(size_t)(m + e) * 832 + n] = f4get(vA, e);
          if (n + 32 < 832) RAW[(size_t)(m + e) * 832 + n + 32] = f4get(vB, e);
        }
      });
    }
  }
  xcd_barrier(xb);
  mla_rownorm_phase(P, j, RAW, QN);
  xcd_barrier(xb);
  {
    const u16* Bq = P.Wuq + (size_t)j * 1536 * 512;
    const u16* Bkv = P.Wukv + (size_t)j * 2048 * 256;
    const int T1 = (MT / 256) * 6, T2 = (KROWS / 256) * 8;
    const float qs = 0.07216878364870322f * LOG2E;
    for (int t = blockIdx.x; t < T1 + T2; t += gridDim.x) {
      const bool isq = t < T1;
      int tm, tn; const u16 *Ap, *Bp; int kdim;
      if (isq) { tm = t % (MT / 256); tn = t / (MT / 256); Ap = QN; Bp = Bq; kdim = 512; }
      else { int t2 = t - T1; tm = t2 % (KROWS / 256); tn = t2 / (KROWS / 256); Ap = CK; Bp = Bkv; kdim = 256; }
      gemm_tile<4>(Ap, kdim, Bp, kdim, kdim, tm * 256, tn * 256, smem, [&](int m, int n, float4 vA, float4 vB) {
        if (isq) {
          auto one = [&](int nn, float4 v) {
            int d = nn % 192;
            bool rp = (d >= 128) && (m >= MP);
#pragma unroll
            for (int e = 0; e < 4; ++e) {
              float val = f4get(v, e);
              if (rp) {
                float partner = __shfl_xor(val, 16);
                val = rope1(val, partner, d - 128, (m + e - MP) & 2047);
              }
              Q[(size_t)(m + e) * 1536 + nn] = f2bf(val * qs);
            }
          };
          one(n, vA);
          one(n + 32, vB);
        } else {
          const int R = m;
          auto one = [&](int nn, float4 v) {
            if (nn < 1024) {
#pragma unroll
              for (int e = 0; e < 4; ++e) Kn[(size_t)(R + e) * 1024 + nn] = f2bf(f4get(v, e));
            } else {
              int c = nn - 1024, hh = c >> 7, dv = c & 127;
              if (R < MP) {
                int b = R >> 8, s = R & 255;
                store_vt4(VtP + ((size_t)(b * 8 + hh) * 128 + dv) * 256 + s, v);
              } else {
                int Rp = R - MP; int b = Rp / 2304; int kk = Rp - b * 2304;
                store_vt4(VtS + ((size_t)(b * 8 + hh) * 128 + dv) * 2304 + kk, v);
              }
            }
          };
          one(n, vA);
          one(n + 32, vB);
        }
      });
    }
  }
  xcd_barrier(xb);
  {
    const int NL = 256, NP = 512;
    const int lat_rounds = (NL + (int)gridDim.x - 1) / (int)gridDim.x, pr_rounds = (NP + VGRID - 1) / VGRID;
    for (int j = 0; j < lat_rounds + pr_rounds; ++j) {
      const bool split = j < lat_rounds;
      int b, hh, m0, kbase, ldv, e1; const u16* vt;
      if (split) {
        const int it = (int)blockIdx.x + j * (int)gridDim.x;
        if (it >= NL) continue;
        b = it >> 7; hh = (it >> 4) & 7; int qb = it & 15;
        m0 = MP + b * 2048 + qb * 128; kbase = MP + b * 2304; ldv = 2304; e1 = 2304;
        vt = VtS + (size_t)(b * 8 + hh) * 128 * 2304;
      } else {
        const int i2 = VBLK + (j - lat_rounds) * VGRID;
        if (i2 >= NP) continue;
        b = i2 >> 4; hh = (i2 >> 1) & 7; int qb = i2 & 1;
        m0 = b * 256 + qb * 128; kbase = b * 256; ldv = 256; e1 = 256;
        vt = VtP + (size_t)(b * 8 + hh) * 128 * 256;
      }
      attn_item<128, 64, 128>(Q, 1536, hh * 192, m0, Kn, 1024, hh * 128, KR, kbase, vt, ldv, e1, 0, 0, false, 0, -1e30f, 0.f,
                              O, DM, hh * 128, smem + VHALF * HALF_LDS, split);
    }
  }
  xcd_barrier(xb);
  gemm_residual_phase(P, O, DM, P.Wmo + (size_t)j * DM * DM, layer, 2, smem);
  xcd_barrier(xb);
}

DI void hgrn_layer(CP P, const XcdBarrier& xb, int layer, char* smem) {
  const size_t MiB = 1048576;
  u16* H = (u16*)P.arena;
  u16* Qh = (u16*)(P.arena + 24 * MiB);
  u16* Vh = (u16*)(P.arena + 48 * MiB);
  u16* Gh = (u16*)(P.arena + 72 * MiB);
  f16* LF = (f16*)(P.arena + 96 * MiB);
  u16* OO = (u16*)(P.arena + 144 * MiB);
  normmod_phase(P, layer, 0, P.in[11] + layer * DM, H);
  xcd_barrier(xb);
  {
    const int tiles = (MT / 256) * 20;
    for (int t = blockIdx.x; t < tiles; t += gridDim.x) {
      int tm = t % (MT / 256), tn = t / (MT / 256);
      gemm_tile<4>(H, DM, P.Wh, DM, DM, tm * 256, tn * 256, smem, [&](int m, int n, float4 vA, float4 vB) {
        const int seg = n >> 10;
        const int c = n & 1023;
        const unsigned gi = (unsigned)m * DM + c;
        if (seg == 0 || seg == 4) {
          u16* dst = seg == 0 ? Qh : Gh;
#pragma unroll
          for (int e = 0; e < 4; ++e) {
            dst[gi + e * DM] = f2bf(silu_f(f4get(vA, e)));
            dst[gi + e * DM + 32] = f2bf(silu_f(f4get(vB, e)));
          }
        } else if (seg == 3) {
#pragma unroll
          for (int e = 0; e < 4; ++e) {
            Vh[gi + e * DM] = f2bf(f4get(vA, e));
            Vh[gi + e * DM + 32] = f2bf(f4get(vB, e));
          }
        } else {
          const float lbA = P.lb[(seg - 1) * 1024 + c], lbB = P.lb[(seg - 1) * 1024 + c + 32];
          f16* lf = LF + (size_t)(seg - 1) * MT * DM;
#pragma unroll
          for (int e = 0; e < 4; ++e) {
            float fA = lbA + (1.f - lbA) * sigmoid_f(f4get(vA, e));
            float fB = lbB + (1.f - lbB) * sigmoid_f(f4get(vB, e));
            lf[gi + e * DM] = (f16)__logf(fA);
            lf[gi + e * DM + 32] = (f16)__logf(fB);
          }
        }
      });
    }
  }
  xcd_barrier(xb);
  float* Lbuf = (float*)P.arena;
  float* Dbuf = (float*)(P.arena + (size_t)15 * MiB);
  for (int ph = 0; ph < 2; ++ph) {
    const int nit = ph == 0 ? 512 : 480;
    for (int it = VBLK; it < nit; it += VGRID) {
      int kind, idx;
      if (ph == 0) { if (it < 224) { kind = 1; idx = it; } else { kind = 0; idx = it - 224; } }
      else { if (it < 256) { kind = 2; idx = it; } else { kind = 0; idx = it - 256 + 288; } }
      hgrn_item(P, kind, idx, Qh, Vh, LF, OO, Lbuf, Dbuf, smem + VHALF * HALF_LDS);
    }
    xcd_barrier(xb);
  }
  hgrn_post_phase(P, OO, OO + (size_t)MT * DM, Gh, H);
  xcd_barrier(xb);
  gemm_residual_phase(P, H, DM, P.Who, layer, 2, smem);
  xcd_barrier(xb);
}

DI void swa_layer(CP P, const XcdBarrier& xb, int layer, char* smem) {
  const size_t MiB = 1048576;
  u16* H = (u16*)P.arena;
  u16* Q = (u16*)(P.arena + 24 * MiB);
  u16* VtP2 = (u16*)(P.arena + 48 * MiB);
  u16* O = (u16*)(P.arena + 52 * MiB);
  normmod_phase(P, layer, 0, P.in[11] + layer * DM, H);
  xcd_barrier(xb);
  {
    const int tiles = (MT / 256) * 6;
    const float qs = 0.125f * LOG2E;
    for (int t = blockIdx.x; t < tiles; t += gridDim.x) {
      int tm = t % (MT / 256), tn = t / (MT / 256);
      gemm_tile<4>(H, DM, P.Wsqkv, DM, DM, tm * 256, tn * 256, smem, [&](int m, int n, float4 vA, float4 vB) {
        auto one = [&](int nn, float4 v) {
          const bool lat = m >= MP;
          if (nn < 1280) {
            const bool isq = nn < 1024;
#pragma unroll
            for (int e = 0; e < 4; ++e) {
              float val = f4get(v, e);
              if (!isq && !lat) P.out[OUT_SK + (size_t)(m + e) * 256 + (nn - 1024)] = val;
              if (lat) {
                float partner = __shfl_xor(val, 16);
                val = rope1(val, partner, nn & 63, (m + e - MP) & 2047);
              }
              if (isq) Q[(size_t)(m + e) * DM + nn] = f2bf(val * qs);
              else P.KSk[(size_t)keyrow_of(m + e) * 256 + (nn - 1024)] = f2bf(val);
            }
          } else {
            int c = nn - 1280, kvh = c >> 6, d = c & 63;
            if (!lat) {
#pragma unroll
              for (int e = 0; e < 4; ++e) P.out[OUT_SV + (size_t)(m + e) * 256 + c] = f4get(v, e);
              int b = m >> 8, s = m & 255;
              store_vt4(VtP2 + ((size_t)(b * 4 + kvh) * 64 + d) * 256 + s, v);
            } else {
              int mm = m - MP; int b = mm >> 11, s = mm & 2047;
              store_vt4(P.VtS2 + ((size_t)(b * 4 + kvh) * 64 + d) * 2304 + 256 + s, v);
            }
          }
        };
        one(n, vA);
        one(n + 32, vB);
      });
    }
  }
  xcd_barrier(xb);
  {
    const int NL = 512, NP = 1024;
    for (int it = VBLK; it < NL + NP; it += VGRID) {
      int b, hq, m0, kbase, ldv, lo2 = 0, hi2 = 0, t0 = 0; bool win = false; const u16* vt;
      if (it < NL) {
        b = it >> 8; hq = (it >> 4) & 15; int qb = it & 15;
        t0 = qb * 128;
        int lo = t0 - 128 < 0 ? 0 : t0 - 128;
        int hi = t0 + 256 > 2048 ? 2048 : t0 + 256;
        lo2 = 256 + lo; hi2 = 256 + hi; win = true;
        m0 = MP + b * 2048 + t0; kbase = MP + b * 2304; ldv = 2304;
        vt = P.VtS2 + (size_t)(b * 4 + (hq >> 2)) * 64 * 2304;
      } else {
        int i2 = it - NL;
        b = i2 >> 5; hq = (i2 >> 1) & 15; int qb = i2 & 1;
        m0 = b * 256 + qb * 128; kbase = b * 256; ldv = 256;
        vt = VtP2 + (size_t)(b * 4 + (hq >> 2)) * 64 * 256;
      }
      float sink = P.in[36][hq] * LOG2E;
      attn_item<64, 0, 64>(Q, DM, hq * 64, m0, P.KSk, 256, (hq >> 2) * 64, nullptr, kbase, vt, ldv, 256, lo2, hi2, win, t0, sink, 1.f,
                           O, DM, hq * 64, smem + VHALF * HALF_LDS);
    }
  }
  xcd_barrier(xb);
  gemm_residual_phase(P, O, DM, P.Wso, layer, 2, smem);
  xcd_barrier(xb);
}

__global__ void __launch_bounds__(512, 2) hybrid_mega(Params Pval) {
  CP P = *(const __attribute__((address_space(4))) Params*)__builtin_amdgcn_kernarg_segment_ptr();
  __shared__ __attribute__((aligned(16))) char smem[SMEM_BYTES];
  if (threadIdx.x < 64) g_hbar[threadIdx.x] = 0u;
  g_tidtab[threadIdx.x] = threadIdx.x;
  __shared__ uint4 xb_words;
  cg::grid_group grid = cg::this_grid();
  if (threadIdx.x == 0) xb_words = make_uint4(0u, 0u, 0u, 0u);
  __syncthreads();
  const XcdBarrier xb = xcd_barrier_post(P.bar, (volatile LAS unsigned*)&xb_words);
  phase0(P, smem + VHALF * HALF_LDS);
  grid.sync();
  mla_layer(P, xb, 0, 0, smem);
  ffn_block(P, xb, 0, smem);
  hgrn_layer(P, xb, 1, smem);
  ffn_block(P, xb, 1, smem);
  swa_layer(P, xb, 2, smem);
  ffn_block(P, xb, 2, smem);
  mla_layer(P, xb, 3, 1, smem);
  ffn_block(P, xb, 3, smem);
  final_norm_phase(P);
}

extern "C" void kernel_launch(void* const* d_in, const int* in_sizes, int n_in, void* d_out, int out_size, void* d_ws, size_t ws_size,
                              hipStream_t stream) {
  static int grid_blocks = 0;
  if (!grid_blocks) {
    int dev = 0, cus = 0, per_cu = 0;
    hipGetDevice(&dev);
    hipDeviceGetAttribute(&cus, hipDeviceAttributeMultiprocessorCount, dev);
    hipOccupancyMaxActiveBlocksPerMultiprocessor(&per_cu, hybrid_mega, 512, 0);
    if (per_cu > 1) per_cu = 1;
    grid_blocks = cus * per_cu;
  }
  Params P{};
  for (int i = 0; i < 37; ++i) P.in[i] = (const float*)d_in[i];
  P.out = (float*)d_out;
  char* ws = (char*)d_ws;
  size_t off = 0;
  auto alloc = [&](size_t bytes) { size_t o = off; off += (bytes + 255) & ~(size_t)255; return ws + o; };
  P.Wgu = (u16*)alloc((size_t)4 * 5632 * DM * 2);
  P.Wd = (u16*)alloc((size_t)4 * DM * DFF * 2);
  P.Wdqkv = (u16*)alloc((size_t)2 * 1024 * DM * 2);
  P.Wuq = (u16*)alloc((size_t)2 * 1536 * 512 * 2);
  P.Wukv = (u16*)alloc((size_t)2 * 2048 * 256 * 2);
  P.Wmo = (u16*)alloc((size_t)2 * DM * DM * 2);
  P.Wh = (u16*)alloc((size_t)5120 * DM * 2);
  P.Who = (u16*)alloc((size_t)DM * DM * 2);
  P.Wsqkv = (u16*)alloc((size_t)1536 * DM * 2);
  P.Wso = (u16*)alloc((size_t)DM * DM * 2);
  P.X = (u16*)alloc((size_t)MT * DM * 2);
  P.mod = (float*)alloc((size_t)4 * 3 * 6144 * 4);
  P.lb = (float*)alloc(2048 * 4);
  P.CKVk = (u16*)alloc((size_t)2 * KROWS * 256 * 2);
  P.KRk = (u16*)alloc((size_t)2 * KROWS * 64 * 2);
  P.KSk = (u16*)alloc((size_t)KROWS * 256 * 2);
  P.VtS2 = (u16*)alloc((size_t)2 * 4 * 64 * 2304 * 2);
  P.arena = alloc((size_t)192 * 1048576);
  P.bar = (unsigned*)alloc(XCD_BAR_WORDS * 4);
  if (off > ws_size) { fprintf(stderr, "workspace too small: need %zu have %zu\n", off, ws_size); return; }
  hipMemsetAsync(P.bar, 0, XCD_BAR_WORDS * 4, stream);
  void* args[] = {&P};
  hipError_t e = hipLaunchCooperativeKernel((void*)hybrid_mega, dim3(grid_blocks), dim3(512), args, 0, stream);
  if (e != hipSuccess) fprintf(stderr, "cooperative launch failed: %s (grid %d)\n", hipGetErrorString(e), grid_blocks);
}
```

```cpp
#include <hip/hip_runtime.h>
#include <hip/hip_cooperative_groups.h>
#include <cstdio>
namespace cg = cooperative_groups;

typedef unsigned short u16;
typedef _Float16 f16;
using bf16x8 = __attribute__((ext_vector_type(8))) short;
using s16x4  = __attribute__((ext_vector_type(4))) short;
using f32x16 = __attribute__((ext_vector_type(16))) float;
using u32x4  = __attribute__((ext_vector_type(4))) unsigned;
using f32x4  = __attribute__((ext_vector_type(4))) float;
#define DI __device__ __forceinline__
#define MFMA32(a, b, c) __builtin_amdgcn_mfma_f32_32x32x16_bf16((a), (b), (c), 0, 0, 0)

#define MP 8192
#define MS 4096
#define MT 12288
#define DM 1024
#define DFF 2816
#define KROWS 12800
#define LOG2E 1.4426950408889634f
#define SMEM_BYTES 147456

struct Params {
  const float* in[37];
  float* out;
  u16 *Wgu, *Wd, *Wdqkv, *Wuq, *Wukv, *Wmo, *Wh, *Who, *Wsqkv, *Wso;
  u16* X;
  float *mod, *lb;
  u16 *CKVk, *KRk, *KSk, *VtS2;
  char* arena;
  unsigned* bar;
};
typedef const __attribute__((address_space(4))) Params& CP;

#define OUT_YP 0
#define OUT_YS 8388608
#define OUT_CKV 12582912
#define OUT_KR 16777216
#define OUT_HG 17825792
#define OUT_SK 26214400
#define OUT_SV 28311552


#define HALF_LDS 73728
#define VTID ((int)(threadIdx.x & 255))
#define VHALF ((int)(threadIdx.x >> 8))
#define VBLK ((int)(blockIdx.x * 2 + (threadIdx.x >> 8)))
#define VGRID ((int)(gridDim.x * 2))
__shared__ unsigned g_hbar[2 * 32];
DI void hbar_impl() {
  asm volatile("s_waitcnt lgkmcnt(0)" ::: "memory");
  if ((threadIdx.x & 63) == 0) {
    unsigned* c = &g_hbar[(threadIdx.x >> 8) * 32];
    const unsigned old = __hip_atomic_fetch_add(c, 1u, __ATOMIC_RELAXED, __HIP_MEMORY_SCOPE_WORKGROUP);
    const unsigned target = (old / 4u + 1u) * 4u;
    while (__hip_atomic_load(c, __ATOMIC_RELAXED, __HIP_MEMORY_SCOPE_WORKGROUP) < target) __builtin_amdgcn_s_sleep(1);
  }
  asm volatile("" ::: "memory");
}
#define HBAR() hbar_impl()
__shared__ int g_tidtab[512];
DI int opq_full() { return ((volatile int*)g_tidtab)[threadIdx.x]; }
DI u16 f2bf(float x) { unsigned u = __float_as_uint(x); u += 0x7fffu + ((u >> 16) & 1u); return (u16)(u >> 16); }
DI float bf2f(u16 v) { return __uint_as_float(((unsigned)v) << 16); }
DI f32x4 ldx4(const u16* p) { const uint2 u = *(const uint2*)p; f32x4 r; r.x = __uint_as_float(u.x << 16); r.y = __uint_as_float(u.x & 0xffff0000u); r.z = __uint_as_float(u.y << 16); r.w = __uint_as_float(u.y & 0xffff0000u); return r; }
DI unsigned pack2(float a, float b) { return (unsigned)f2bf(a) | ((unsigned)f2bf(b) << 16); }
DI bf16x8 pack8(float a0, float a1, float a2, float a3, float a4, float a5, float a6, float a7) {
  u32x4 p; p[0] = pack2(a0, a1); p[1] = pack2(a2, a3); p[2] = pack2(a4, a5); p[3] = pack2(a6, a7);
  return __builtin_bit_cast(bf16x8, p);
}
DI float silu_f(float x) { return x * __builtin_amdgcn_rcpf(1.f + __expf(-x)); }
DI float sigmoid_f(float x) { return __builtin_amdgcn_rcpf(1.f + __expf(-x)); }
DI int crow(int i, int h) { return (i & 3) + 8 * (i >> 2) + 4 * h; }
DI int keyrow_of(int m) {
  if (m < MP) return m;
  int mm = m - MP; int b = mm >> 11; int s = mm & 2047;
  return MP + b * 2304 + 256 + s;
}
DI int grp_of(int m) { return m < MP ? 0 : 1 + ((m - MP) >> 11); }
DI float rope1(float v, float partner, int d64, int s) {
  int jj = d64 & 15;
  float pos = (float)((d64 & 32) ? (s & 63) : (s >> 6));
  float inv = __builtin_amdgcn_exp2f(-(float)jj * 0.83048202372184058696f);
  float ang = pos * inv;
  float sn = __sinf(ang), cs = __cosf(ang);
  return (d64 & 16) ? (partner * sn + v * cs) : (v * cs - partner * sn);
}


#define XB_TMO      128
#define XB_XCNT(j)  (256  + 64 * (j))
#define XB_XSUB(j)  (1280 + 64 * (j))
#define XB_XGEN(j)  (2304 + 64 * (j))
#define XB_TOP      3328
#define XB_TOPGEN   3392
#define XCD_BAR_WORDS 3456
#define XB_SPIN_CAP (1u << 18)
#define LAS __attribute__((address_space(3)))
DI unsigned xb_ld(unsigned* p)              { return __hip_atomic_load(p, __ATOMIC_RELAXED, __HIP_MEMORY_SCOPE_AGENT); }
DI unsigned xb_add(unsigned* p, unsigned v) { return __hip_atomic_fetch_add(p, v, __ATOMIC_RELAXED, __HIP_MEMORY_SCOPE_AGENT); }
DI unsigned xb_xcc_id() { return (unsigned)__builtin_amdgcn_s_getreg((3 << 11) | 20) & 0xFu; }
#define XB_SPIN(cond, bar) do { unsigned _sp = 0; while (cond) { __builtin_amdgcn_s_sleep(1); \
    if ((++_sp & 255u) == 0u) { if (xb_ld(&(bar)[XB_TMO])) break; if (_sp > XB_SPIN_CAP) { atomicAdd(&(bar)[XB_TMO], 1u); break; } } } } while (0)
struct XcdBarrier { unsigned* bar; unsigned x; volatile LAS unsigned* st; };
DI XcdBarrier xcd_barrier_post(unsigned* bar, volatile LAS unsigned* st) {
  XcdBarrier b; b.bar = bar; b.x = xb_xcc_id(); b.st = st;
  if (threadIdx.x == 0) (void)xb_add(&bar[XB_XCNT(b.x)], 1u);
  return b;
}
DI void xcd_barrier_complete(unsigned* bar, unsigned x, unsigned& nloc, unsigned& nx) {
  const unsigned G = gridDim.x * gridDim.y * gridDim.z;
  unsigned sum, cnt, mine, sp = 0u;
  for (;;) {
    sum = 0u; cnt = 0u; mine = 0u;
#pragma unroll
    for (unsigned j = 0; j < 16; ++j) { const unsigned c = xb_ld(&bar[XB_XCNT(j)]); sum += c; cnt += (c > 0u) ? 1u : 0u; mine = (j == x) ? c : mine; }
    if (sum == G) break;
    __builtin_amdgcn_s_sleep(1);
    if ((++sp & 255u) == 0u) { if (xb_ld(&bar[XB_TMO])) break; if (sp > XB_SPIN_CAP) { atomicAdd(&bar[XB_TMO], 1u); break; } }
  }
  nloc = mine > 0u ? mine : 1u; nx = cnt > 0u ? cnt : 1u;
}
DI void xcd_barrier(const XcdBarrier& b) {
  asm volatile("s_waitcnt vmcnt(0)" ::: "memory");
  __syncthreads();
  if (threadIdx.x == 0) {
    unsigned* bar = b.bar;
    __builtin_amdgcn_s_waitcnt(0);
    unsigned nloc = b.st[0], nx = b.st[1];
    if (nloc == 0u) { xcd_barrier_complete(bar, b.x, nloc, nx); b.st[0] = nloc; b.st[1] = nx; }
    const unsigned old = xb_add(&bar[XB_XSUB(b.x)], 1u);
    const unsigned gen = old / nloc;
    if (old + 1u == (gen + 1u) * nloc) {
      __builtin_amdgcn_fence(__ATOMIC_RELEASE, "agent");
      asm volatile("s_waitcnt vmcnt(0)" ::: "memory");
      const unsigned og = xb_add(&bar[XB_TOP], 1u);
      const unsigned tg = og / nx;
      if (og + 1u == (tg + 1u) * nx) xb_add(&bar[XB_TOPGEN], 1u);
      else XB_SPIN(xb_ld(&bar[XB_TOPGEN]) == tg, bar);
      __builtin_amdgcn_fence(__ATOMIC_ACQUIRE, "agent");
      xb_add(&bar[XB_XGEN(b.x)], 1u);
      asm volatile("s_waitcnt vmcnt(0)" ::: "memory");
    } else {
      XB_SPIN(xb_ld(&bar[XB_XGEN(b.x)]) == gen, bar);
      __builtin_amdgcn_fence(__ATOMIC_ACQUIRE, "agent");
      asm volatile("s_waitcnt vmcnt(0)" ::: "memory");
    }
  }
  __syncthreads();
}

#define RAW_BARRIER() do { asm volatile("s_waitcnt lgkmcnt(0)" ::: "memory"); __builtin_amdgcn_s_barrier(); asm volatile("" ::: "memory"); } while (0)
template <int NJ, class Epi>
DI void gemm_tile(const u16* __restrict__ A, int lda, const u16* __restrict__ B, int ldb, int K, int m0, int n0, char* smem, Epi&& epi) {
  constexpr int BN = 64 * NJ;
  constexpr int NBI = BN / 128;
  constexpr int SA_BYTES = 256 * 64, SB_BYTES = BN * 64, STAGE = SA_BYTES + SB_BYTES;
  constexpr int NLD = 2 + NBI;
  static_assert(NLD == 4 || NLD == 3, "vmcnt immediates below assume this");
  const int tid = opq_full(), lane = tid & 63, w = tid >> 6, r = lane & 31, h = lane >> 5;
  const int wm = w >> 1, wn = w & 1;
  f32x16 acc[2][NJ];
#pragma unroll
  for (int i = 0; i < 2; ++i)
#pragma unroll
    for (int j = 0; j < NJ; ++j)
#pragma unroll
      for (int e = 0; e < 16; ++e) acc[i][j][e] = 0.f;
  const int drow = lane >> 2, dch = (lane & 3) ^ (lane >> 4);
  const u16* ga0 = A + (size_t)(m0 + (w * 2 + 0) * 16 + drow) * lda + dch * 8;
  const u16* ga1 = A + (size_t)(m0 + (w * 2 + 1) * 16 + drow) * lda + dch * 8;
  const u16* gb0 = B + (size_t)(n0 + (w * NBI + 0) * 16 + drow) * ldb + dch * 8;
  const u16* gb1 = B + (size_t)(n0 + (w * NBI + (NBI - 1)) * 16 + drow) * ldb + dch * 8;
  const int nk = K >> 5;
  const int rot = (m0 >> 8) % nk;
  auto issue = [&](int j, int buf) {
    int jj = j < nk ? j : nk - 1;
    int kk = rot + jj; kk = kk >= nk ? kk - nk : kk;
    const int k0 = kk * 32;
    char* sb_ = smem + buf * STAGE;
    __builtin_amdgcn_global_load_lds((const unsigned*)(ga0 + k0), (__attribute__((address_space(3))) unsigned*)(sb_ + (w * 2 + 0) * 1024), 16, 0, 0);
    __builtin_amdgcn_global_load_lds((const unsigned*)(ga1 + k0), (__attribute__((address_space(3))) unsigned*)(sb_ + (w * 2 + 1) * 1024), 16, 0, 0);
    __builtin_amdgcn_global_load_lds((const unsigned*)(gb0 + k0), (__attribute__((address_space(3))) unsigned*)(sb_ + SA_BYTES + (w * NBI + 0) * 1024), 16, 0, 0);
    if (NBI == 2)
      __builtin_amdgcn_global_load_lds((const unsigned*)(gb1 + k0), (__attribute__((address_space(3))) unsigned*)(sb_ + SA_BYTES + (w * NBI + 1) * 1024), 16, 0, 0);
  };
  const unsigned sw = (unsigned)((r >> 2) & 3);
  const unsigned sbase = (unsigned)(size_t)smem;
  const unsigned so0 = ((0u * 2u + (unsigned)h) ^ sw) * 16u, so1 = ((1u * 2u + (unsigned)h) ^ sw) * 16u;
  const unsigned rowA = (unsigned)(wm * 64 + r) * 64u, rowB = (unsigned)SA_BYTES + (unsigned)(wn * 32 * NJ + r) * 64u;
#define LDS_RD(dst, addr, OFF) asm volatile("ds_read_b128 %0, %1 offset:%2" : "=v"(dst) : "v"(addr), "n"(OFF) : "memory")
  __syncthreads();
  issue(0, 0); issue(1, 1); issue(2, 2);
  for (int kt = 0; kt < nk; ++kt) {
    if (NLD == 4) asm volatile("s_waitcnt vmcnt(8)" ::: "memory"); else asm volatile("s_waitcnt vmcnt(6)" ::: "memory");
    RAW_BARRIER();
    issue(kt + 3, (kt + 3) & 3);
    const unsigned st = sbase + (unsigned)(kt & 3) * (unsigned)STAGE;
    const unsigned pa0 = st + rowA + so0, pa1 = st + rowA + so1, pb0 = st + rowB + so0, pb1 = st + rowB + so1;
    bf16x8 a00, a10, a01, a11, b0[NJ], b1[NJ];
    LDS_RD(a00, pa0, 0); LDS_RD(a10, pa0, 2048);
    LDS_RD(b0[0], pb0, 0); LDS_RD(b0[1], pb0, 2048);
    if (NJ == 4) { LDS_RD(b0[NJ - 2], pb0, 4096); LDS_RD(b0[NJ - 1], pb0, 6144); }
    LDS_RD(a01, pa1, 0); LDS_RD(a11, pa1, 2048);
    LDS_RD(b1[0], pb1, 0); LDS_RD(b1[1], pb1, 2048);
    if (NJ == 4) { LDS_RD(b1[NJ - 2], pb1, 4096); LDS_RD(b1[NJ - 1], pb1, 6144); }
    if (NJ == 4) asm volatile("s_waitcnt lgkmcnt(6)" : "+v"(a00), "+v"(a10), "+v"(b0[0]), "+v"(b0[1]), "+v"(b0[NJ - 2]), "+v"(b0[NJ - 1]) :: "memory");
    else asm volatile("s_waitcnt lgkmcnt(4)" : "+v"(a00), "+v"(a10), "+v"(b0[0]), "+v"(b0[1]) :: "memory");
#pragma unroll
    for (int j = 0; j < NJ; ++j) {
      acc[0][j] = MFMA32(a00, b0[j], acc[0][j]);
      acc[1][j] = MFMA32(a10, b0[j], acc[1][j]);
    }
    if (NJ == 4) asm volatile("s_waitcnt lgkmcnt(0)" : "+v"(a01), "+v"(a11), "+v"(b1[0]), "+v"(b1[1]), "+v"(b1[NJ - 2]), "+v"(b1[NJ - 1]) :: "memory");
    else asm volatile("s_waitcnt lgkmcnt(0)" : "+v"(a01), "+v"(a11), "+v"(b1[0]), "+v"(b1[1]) :: "memory");
#pragma unroll
    for (int j = 0; j < NJ; ++j) {
      acc[0][j] = MFMA32(a01, b1[j], acc[0][j]);
      acc[1][j] = MFMA32(a11, b1[j], acc[1][j]);
    }
  }
  asm volatile("s_waitcnt vmcnt(0)" ::: "memory");
#pragma unroll
  for (int i = 0; i < 2; ++i)
#pragma unroll
    for (int g = 0; g < 4; ++g) {
      int m = m0 + wm * 64 + i * 32 + 8 * g + 4 * h;
#pragma unroll
      for (int jp = 0; jp < NJ / 2; ++jp) {
        float4 vA = make_float4(acc[i][2 * jp][4 * g], acc[i][2 * jp][4 * g + 1], acc[i][2 * jp][4 * g + 2], acc[i][2 * jp][4 * g + 3]);
        float4 vB = make_float4(acc[i][2 * jp + 1][4 * g], acc[i][2 * jp + 1][4 * g + 1], acc[i][2 * jp + 1][4 * g + 2], acc[i][2 * jp + 1][4 * g + 3]);
        epi(m, n0 + wn * 32 * NJ + jp * 64 + r, vA, vB);
      }
    }
}

DI float f4get(const float4& v, int e) { return e == 0 ? v.x : e == 1 ? v.y : e == 2 ? v.z : v.w; }

struct ConvP { const float* src; u16* dst; int N, ldd, row0, mode, k0, n0; };
DI ConvP conv_params(CP P, int t) {
  const float* src = nullptr; u16* dst = nullptr; int K = 0, N = 64, ldd = 0, row0 = 0, mode = 0; bool found = false;
#define TRY(SRC, KK, NN, DST, LDD, ROW0, MODE)                                   \
  if (!found) { int nt_ = ((KK) / 64) * ((NN) / 64);                              \
    if (t < nt_) { src = (SRC); K = (KK); N = (NN); dst = (DST); ldd = (LDD); row0 = (ROW0); mode = (MODE); found = true; } else t -= nt_; }
#pragma unroll
  for (int i = 0; i < 4; ++i) {
    TRY(P.in[13] + (size_t)i * DM * DFF, DM, DFF, P.Wgu + (size_t)i * 5632 * DM, DM, 0, 1)
    TRY(P.in[14] + (size_t)i * DM * DFF, DM, DFF, P.Wgu + (size_t)i * 5632 * DM, DM, 0, 2)
    TRY(P.in[15] + (size_t)i * DFF * DM, DFF, DM, P.Wd + (size_t)i * DM * DFF, DFF, 0, 0)
  }
#pragma unroll
  for (int j = 0; j < 2; ++j) {
    TRY(P.in[17] + (size_t)j * DM * 512, DM, 512, P.Wdqkv + (size_t)j * 1024 * DM, DM, 0, 0)
    TRY(P.in[20] + (size_t)j * DM * 320, DM, 320, P.Wdqkv + (size_t)j * 1024 * DM, DM, 512, 0)
    TRY(P.in[19] + (size_t)j * 512 * 1536, 512, 1536, P.Wuq + (size_t)j * 1536 * 512, 512, 0, 0)
    TRY(P.in[22] + (size_t)j * 256 * 1024, 256, 1024, P.Wukv + (size_t)j * 2048 * 256, 256, 0, 0)
    TRY(P.in[23] + (size_t)j * 256 * 1024, 256, 1024, P.Wukv + (size_t)j * 2048 * 256, 256, 1024, 0)
    TRY(P.in[24] + (size_t)j * DM * DM, DM, DM, P.Wmo + (size_t)j * DM * DM, DM, 0, 0)
  }
  TRY(P.in[25], DM, DM, P.Wh, DM, 0, 0)
  TRY(P.in[26], DM, DM, P.Wh, DM, 1024, 0)
  TRY(P.in[26] + (size_t)DM * DM, DM, DM, P.Wh, DM, 2048, 0)
  TRY(P.in[27], DM, DM, P.Wh, DM, 3072, 0)
  TRY(P.in[28], DM, DM, P.Wh, DM, 4096, 0)
  TRY(P.in[30], DM, DM, P.Who, DM, 0, 0)
  TRY(P.in[32], DM, DM, P.Wsqkv, DM, 0, 0)
  TRY(P.in[33], DM, 256, P.Wsqkv, DM, 1024, 0)
  TRY(P.in[34], DM, 256, P.Wsqkv, DM, 1280, 0)
  TRY(P.in[35], DM, DM, P.Wso, DM, 0, 0)
#undef TRY
  const int ntn = N / 64;
  const int tk = t / ntn, tn = t - tk * ntn;
  ConvP c; c.src = src; c.dst = dst; c.N = N; c.ldd = ldd; c.row0 = row0; c.mode = mode; c.k0 = tk * 64; c.n0 = tn * 64;
  return c;
}
#define CONV_LOAD(c, v0, v1, v2, v3, tid) do {                                                                         \
    const float* sp_ = (c).src + (size_t)((c).k0 + ((tid) >> 4)) * (c).N + (c).n0 + ((tid) & 15) * 4;                   \
    v0 = *(const f32x4*)(sp_); v1 = *(const f32x4*)(sp_ + (size_t)16 * (c).N);                                          \
    v2 = *(const f32x4*)(sp_ + (size_t)32 * (c).N); v3 = *(const f32x4*)(sp_ + (size_t)48 * (c).N); } while (0)
DI void conv_store(const ConvP& c, f32x4 v0, f32x4 v1, f32x4 v2, f32x4 v3, int tid, char* smem) {
  u16* t = (u16*)smem;
  HBAR();
  const int k = tid >> 4, n4 = (tid & 15) * 4;
#pragma unroll
  for (int j = 0; j < 4; ++j) {
    t[(n4 + j) * 72 + k] = f2bf(v0[j]);
    t[(n4 + j) * 72 + k + 16] = f2bf(v1[j]);
    t[(n4 + j) * 72 + k + 32] = f2bf(v2[j]);
    t[(n4 + j) * 72 + k + 48] = f2bf(v3[j]);
  }
  HBAR();
  const int n = tid >> 2, q = tid & 3;
  const int nn = c.n0 + n;
  const int row = c.mode == 0 ? c.row0 + nn : ((nn >> 5) * 64 + (c.mode == 2 ? 32 : 0) + (nn & 31));
  uint4 a = *(const uint4*)(t + n * 72 + q * 16);
  uint4 b = *(const uint4*)(t + n * 72 + q * 16 + 8);
  u16* d = c.dst + (size_t)row * c.ldd + c.k0 + q * 16;
  *(uint4*)d = a;
  *(uint4*)(d + 8) = b;
}
#define N_CONV_TILES 12192

DI void adaln_item(CP P, int it, char* smem) {
  const int i = it / 96, cb = it - i * 96;
  float* s = (float*)smem;
  const int tid = (opq_full() & 255);
  HBAR();
  for (int e = tid; e < 3072; e += 256) {
    int rr = e >> 10, k = e & 1023;
    float c = rr == 0 ? P.in[8][k] : P.in[7][(rr - 1) * 1024 + k];
    s[e] = silu_f(c);
  }
  HBAR();
  const int kg = tid >> 4, c4 = (tid & 15) * 4;
  const float* wp = P.in[9] + ((size_t)i * 1024 + kg * 64) * 6144 + cb * 64 + c4;
  f32x4 a0 = {0.f, 0.f, 0.f, 0.f}, a1 = a0, a2 = a0;
#pragma unroll 16
  for (int k = 0; k < 64; ++k) {
    f32x4 wv = *(const f32x4*)(wp + (size_t)k * 6144);
    a0 += s[kg * 64 + k] * wv;
    a1 += s[1024 + kg * 64 + k] * wv;
    a2 += s[2048 + kg * 64 + k] * wv;
  }
  float* red = s + 3072;
  *(f32x4*)(red + (kg * 3 + 0) * 64 + c4) = a0;
  *(f32x4*)(red + (kg * 3 + 1) * 64 + c4) = a1;
  *(f32x4*)(red + (kg * 3 + 2) * 64 + c4) = a2;
  HBAR();
  if (tid < 192) {
    const int rr = tid >> 6, c2 = tid & 63;
    float sum = 0.f;
#pragma unroll
    for (int g = 0; g < 16; ++g) sum += red[(g * 3 + rr) * 64 + c2];
    const int nn = cb * 64 + c2;
    P.mod[(size_t)(i * 3 + rr) * 6144 + nn] = sum + P.in[10][i * 6144 + nn];
  }
}

DI void misc_item(CP P, int it) {
  const int tid = (opq_full() & 255);
  for (int p = 0; p < 8; ++p) {
    int e = it * 2048 + p * 256 + tid;
    if (e < 262144) {
      int c = e & 255, l = (e >> 8) & 255, j = (e >> 16) & 1, b = e >> 17;
      P.CKVk[((size_t)j * KROWS + MP + b * 2304 + l) * 256 + c] = f2bf(P.in[2][e]);
    } else if (e < 262144 + 65536) {
      int e2 = e - 262144;
      int c = e2 & 63, l = (e2 >> 6) & 255, j = (e2 >> 14) & 1, b = e2 >> 15;
      P.KRk[((size_t)j * KROWS + MP + b * 2304 + l) * 64 + c] = f2bf(P.in[3][e2]);
    } else if (e < 262144 + 65536 + 131072) {
      int e2 = e - 327680;
      int c = e2 & 255, l = (e2 >> 8) & 255, b = e2 >> 16;
      P.KSk[((size_t)MP + b * 2304 + l) * 256 + c] = f2bf(P.in[5][e2]);
    } else if (e < 589824) {
      int e2 = e - 458752;
      int d = e2 & 63, kvh = (e2 >> 6) & 3, l = (e2 >> 8) & 255, b = e2 >> 16;
      P.VtS2[((size_t)(b * 4 + kvh) * 64 + d) * 2304 + l] = f2bf(P.in[6][e2]);
    }
  }
}
#define N_MISC_ITEMS 288

DI void phase0(CP P, char* smem) {
  const int tid = (opq_full() & 255);
  const int vb = VBLK, vg = VGRID;
  {
    int t = vb;
    ConvP cur; f32x4 v0, v1, v2, v3;
    if (t < N_CONV_TILES) { cur = conv_params(P, t); CONV_LOAD(cur, v0, v1, v2, v3, tid); }
    for (; t < N_CONV_TILES; t += vg) {
      const int tn = t + vg;
      ConvP nx = cur; f32x4 w0 = v0, w1 = v1, w2 = v2, w3 = v3;
      if (tn < N_CONV_TILES) { nx = conv_params(P, tn); CONV_LOAD(nx, w0, w1, w2, w3, tid); }
      conv_store(cur, v0, v1, v2, v3, tid, smem);
      cur = nx; v0 = w0; v1 = w1; v2 = w2; v3 = w3;
    }
  }
  for (int it = vg - 1 - vb; it < 384; it += vg) adaln_item(P, it, smem);
  for (int it = vb; it < N_MISC_ITEMS + 2; it += vg) {
    if (it < N_MISC_ITEMS) { misc_item(P, it); continue; }
    if (it == N_MISC_ITEMS) {
      for (int e = tid; e < 2048; e += 256) {
        int d = e >> 10, kd = e & 1023;
        const float* lg = P.in[31] + (size_t)d * 4 * 1024 + kd;
        float l0 = lg[0], l1 = lg[1024], l2 = lg[2048], l3 = lg[3072];
        float mx = fmaxf(fmaxf(l0, l1), fmaxf(l2, l3));
        float e0 = __expf(l0 - mx), e1 = __expf(l1 - mx), e2 = __expf(l2 - mx), e3 = __expf(l3 - mx);
        P.lb[e] = e1 / (e0 + e1 + e2 + e3);
      }
    } else {
      for (int e = tid; e < 2 * 192 * 1024 / 8; e += 256) {
        int j = e / (192 * 128), rem = e - j * 192 * 128;
        *(uint4*)(P.Wdqkv + (size_t)j * 1024 * DM + (size_t)832 * DM + (size_t)rem * 8) = make_uint4(0, 0, 0, 0);
      }
    }
  }
}

DI float wave_sum(float v) {
#pragma unroll
  for (int o = 32; o >= 1; o >>= 1) v += __shfl_xor(v, o);
  return v;
}

DI void normmod_phase(CP P, int layer, int which  , const float* gain, u16* H, bool first = false) {
  const int tid_ = (opq_full() & 255); const int lane = tid_ & 63, w = tid_ >> 6;
  const int stride = VGRID * 4;
  int m = VBLK * 4 + w;
  f32x4 g[4], v[4];
#pragma unroll
  for (int i = 0; i < 4; ++i) g[i] = *(const f32x4*)(gain + (i * 64 + lane) * 4);
  if (m < MT) {
    if (first) {
      const float* x = m < MP ? P.in[0] + (size_t)m * DM : P.in[1] + (size_t)(m - MP) * DM;
#pragma unroll
      for (int i = 0; i < 4; ++i) v[i] = *(const f32x4*)(x + (i * 64 + lane) * 4);
    } else {
#pragma unroll
      for (int i = 0; i < 4; ++i) v[i] = ldx4(P.X + (size_t)m * DM + (i * 64 + lane) * 4);
    }
  }
  for (; m < MT; m += stride) {
    const int mn = m + stride;
    f32x4 nv[4];
#pragma unroll
    for (int i = 0; i < 4; ++i) nv[i] = v[i];
    if (mn < MT) {
      if (first) {
        const float* xn = mn < MP ? P.in[0] + (size_t)mn * DM : P.in[1] + (size_t)(mn - MP) * DM;
#pragma unroll
        for (int i = 0; i < 4; ++i) nv[i] = *(const f32x4*)(xn + (i * 64 + lane) * 4);
      } else {
#pragma unroll
        for (int i = 0; i < 4; ++i) nv[i] = ldx4(P.X + (size_t)mn * DM + (i * 64 + lane) * 4);
      }
    }
    const float* md = P.mod + (size_t)(layer * 3 + grp_of(m)) * 6144 + which * 3072;
    f32x4 sh[4], sc[4];
#pragma unroll
    for (int i = 0; i < 4; ++i) { sh[i] = *(const f32x4*)(md + (i * 64 + lane) * 4); sc[i] = *(const f32x4*)(md + 1024 + (i * 64 + lane) * 4); }
    float ss = 0.f;
#pragma unroll
    for (int i = 0; i < 4; ++i) ss += v[i].x * v[i].x + v[i].y * v[i].y + v[i].z * v[i].z + v[i].w * v[i].w;
    if (first) {
#pragma unroll
      for (int i = 0; i < 4; ++i) *(uint2*)(P.X + (size_t)m * DM + (i * 64 + lane) * 4) = make_uint2(pack2(v[i].x, v[i].y), pack2(v[i].z, v[i].w));
    }
    ss = wave_sum(ss);
    const float rstd = rsqrtf(ss * (1.f / DM) + 1e-6f);
#pragma unroll
    for (int i = 0; i < 4; ++i) {
      const int c = (i * 64 + lane) * 4;
      f32x4 o = v[i] * rstd * g[i] * (1.f + sc[i]) + sh[i];
      *(uint2*)(H + (size_t)m * DM + c) = make_uint2(pack2(o.x, o.y), pack2(o.z, o.w));
    }
#pragma unroll
    for (int i = 0; i < 4; ++i) v[i] = nv[i];
  }
}

DI void final_norm_phase(CP P) {
  const int tid_ = (opq_full() & 255); const int lane = tid_ & 63, w = tid_ >> 6;
  for (int m = VBLK * 4 + w; m < MT; m += VGRID * 4) {
    const u16* x = P.X + (size_t)m * DM;
    f32x4 v[4]; float ss = 0.f;
#pragma unroll
    for (int i = 0; i < 4; ++i) { v[i] = ldx4(x + (i * 64 + lane) * 4); ss += v[i].x * v[i].x + v[i].y * v[i].y + v[i].z * v[i].z + v[i].w * v[i].w; }
    ss = wave_sum(ss);
    float rstd = rsqrtf(ss * (1.f / DM) + 1e-6f);
#pragma unroll
    for (int i = 0; i < 4; ++i) {
      int c = (i * 64 + lane) * 4;
      float4 g = *(const float4*)(P.in[16] + c);
      *(float4*)(P.out + (size_t)m * DM + c) = make_float4(v[i].x * rstd * g.x, v[i].y * rstd * g.y, v[i].z * rstd * g.z, v[i].w * rstd * g.w);
    }
  }
}

DI void mla_rownorm_phase(CP P, int j, const u16* RAW, u16* QN) {
  const int tid_ = (opq_full() & 255); const int lane = tid_ & 63, w = tid_ >> 6;
  const float* qg = P.in[18] + j * 512;
  const float* kg = P.in[21] + j * 256;
  u16* CK = P.CKVk + (size_t)j * KROWS * 256;
  u16* KR = P.KRk + (size_t)j * KROWS * 64;
  for (int m = VBLK * 4 + w; m < MT; m += VGRID * 4) {
    const u16* x = RAW + (size_t)m * 832;
    const f32x4 q0 = ldx4(x + lane * 4), q1 = ldx4(x + 256 + lane * 4);
    const f32x4 kv = ldx4(x + 512 + lane * 4);
    float kr = bf2f(x[768 + lane]);
    float sq = q0.x * q0.x + q0.y * q0.y + q0.z * q0.z + q0.w * q0.w + q1.x * q1.x + q1.y * q1.y + q1.z * q1.z + q1.w * q1.w;
    float sk = kv.x * kv.x + kv.y * kv.y + kv.z * kv.z + kv.w * kv.w;
    sq = wave_sum(sq); sk = wave_sum(sk);
    float rq = rsqrtf(sq * (1.f / 512.f) + 1e-6f), rk = rsqrtf(sk * (1.f / 256.f) + 1e-6f);
    float4 g0 = *(const float4*)(qg + lane * 4), g1 = *(const float4*)(qg + 256 + lane * 4), g2 = *(const float4*)(kg + lane * 4);
    *(uint2*)(QN + (size_t)m * 512 + lane * 4) = make_uint2(pack2(q0.x * rq * g0.x, q0.y * rq * g0.y), pack2(q0.z * rq * g0.z, q0.w * rq * g0.w));
    *(uint2*)(QN + (size_t)m * 512 + 256 + lane * 4) = make_uint2(pack2(q1.x * rq * g1.x, q1.y * rq * g1.y), pack2(q1.z * rq * g1.z, q1.w * rq * g1.w));
    float4 c = make_float4(kv.x * rk * g2.x, kv.y * rk * g2.y, kv.z * rk * g2.z, kv.w * rk * g2.w);
    const int kr_row = keyrow_of(m);
    *(uint2*)(CK + (size_t)kr_row * 256 + lane * 4) = make_uint2(pack2(c.x, c.y), pack2(c.z, c.w));
    float partner = __shfl_xor(kr, 16);
    if (m < MP) {
      int b = m >> 8, s = m & 255;
      *(float4*)(P.out + OUT_CKV + ((size_t)(b * 2 + j) * 256 + s) * 256 + lane * 4) = c;
      P.out[OUT_KR + ((size_t)(b * 2 + j) * 256 + s) * 64 + lane] = kr;
      KR[(size_t)kr_row * 64 + lane] = f2bf(kr);
    } else {
      int s = (m - MP) & 2047;
      KR[(size_t)kr_row * 64 + lane] = f2bf(rope1(kr, partner, lane, s));
    }
  }
}

DI void hgrn_post_phase(CP P, const u16* Of, const u16* Ob, const u16* Gh, u16* A2) {
  const int tid_ = (opq_full() & 255); const int lane = tid_ & 63, w = tid_ >> 6;
  for (int m = VBLK * 4 + w; m < MT; m += VGRID * 4) {
#pragma unroll
    for (int i = 0; i < 4; ++i) {
      int c = (i * 64 + lane) * 4;
      uint2 a = *(const uint2*)(Of + (size_t)m * DM + c), b = *(const uint2*)(Ob + (size_t)m * DM + c), g = *(const uint2*)(Gh + (size_t)m * DM + c);
      float o0 = bf2f((u16)(a.x & 0xffff)) + bf2f((u16)(b.x & 0xffff));
      float o1 = bf2f((u16)(a.x >> 16)) + bf2f((u16)(b.x >> 16));
      float o2 = bf2f((u16)(a.y & 0xffff)) + bf2f((u16)(b.y & 0xffff));
      float o3 = bf2f((u16)(a.y >> 16)) + bf2f((u16)(b.y >> 16));
      float ss = o0 * o0 + o1 * o1 + o2 * o2 + o3 * o3;
#pragma unroll
      for (int o = 16; o >= 1; o >>= 1) ss += __shfl_xor(ss, o);
      float rstd = rsqrtf(ss * (1.f / 128.f) + 1e-6f);
      float4 gn = *(const float4*)(P.in[29] + (c & 127));
      o0 = o0 * rstd * gn.x * bf2f((u16)(g.x & 0xffff));
      o1 = o1 * rstd * gn.y * bf2f((u16)(g.x >> 16));
      o2 = o2 * rstd * gn.z * bf2f((u16)(g.y & 0xffff));
      o3 = o3 * rstd * gn.w * bf2f((u16)(g.y >> 16));
      *(uint2*)(A2 + (size_t)m * DM + c) = make_uint2(pack2(o0, o1), pack2(o2, o3));
    }
  }
}

template <int DKN, int DKR, int DV>
DI void attn_item(const u16* __restrict__ Q, int ldq, int qoff, int m0,
                  const u16* __restrict__ Kn, int ldk, int koff, const u16* __restrict__ Kr, int kbase,
                  const u16* __restrict__ Vt, int ldv,
                  int e1, int lo2, int hi2, bool win, int t0, float m_init, float l_init,
                  u16* __restrict__ O, int ldo, int ooff, char* smem, bool split = false) {
  constexpr int DK = DKN + DKR;
  constexpr int KST = DK * 2 + 16;
  constexpr int KBYTES = 32 * KST;
  constexpr int VBYTES = DV * 80;
  constexpr int STAGE = KBYTES + VBYTES;
  constexpr int KCH = DK / 8;
  constexpr int NKL = (32 * KCH) / 256;
  constexpr int NVL = (DV * 4) / 256;
  const int tfull = opq_full();
  const int tid = tfull & 255, vh = tfull >> 8, lane = tid & 63, w = tid >> 6, r = lane & 31, h = lane >> 5;

  bf16x8 qf[DK / 16];
  {
    const u16* qp = Q + (size_t)(m0 + w * 32 + r) * ldq + qoff + h * 8;
#pragma unroll
    for (int ks = 0; ks < DK / 16; ++ks) qf[ks] = *(const bf16x8*)(qp + ks * 16);
  }
  f32x16 o[DV / 32];
#pragma unroll
  for (int d = 0; d < DV / 32; ++d)
#pragma unroll
    for (int e = 0; e < 16; ++e) o[d][e] = 0.f;
  float mrun = m_init, lrun = (h == 0) ? l_init : 0.f;

  const int n1 = e1 >> 5;
  const int nsteps = n1 + ((hi2 - lo2) >> 5);
  const int sbeg = split ? vh * (nsteps >> 1) : 0;
  const int send = split ? sbeg + (nsteps >> 1) : nsteps;
  u32x4 rk[NKL], rv[NVL];
  auto gload = [&](int st) {
    const int kk = st < n1 ? st * 32 : lo2 + (st - n1) * 32;
#pragma unroll
    for (int i = 0; i < NKL; ++i) {
      int c = tid + 256 * i;
      int row = c / KCH, cc = c - row * KCH;
      size_t kr_ = (size_t)(kbase + kk + row);
      const u16* src = (cc < DKN / 8) ? (Kn + kr_ * ldk + koff + cc * 8) : (Kr + kr_ * 64 + (cc - DKN / 8) * 8);
      rk[i] = *(const u32x4*)src;
    }
#pragma unroll
    for (int i = 0; i < NVL; ++i) {
      int c = tid + 256 * i;
      int row = c >> 2, cc = c & 3;
      rv[i] = *(const u32x4*)(Vt + (size_t)row * ldv + kk + cc * 8);
    }
  };
  gload(sbeg);
  HBAR();
  for (int st = sbeg; st < send; ++st) {
    char* sk = smem + ((st - sbeg) & 1) * STAGE;
    char* sv = sk + KBYTES;
#pragma unroll
    for (int i = 0; i < NKL; ++i) {
      int c = tid + 256 * i;
      int row = c / KCH, cc = c - row * KCH;
      *(u32x4*)(sk + row * KST + cc * 16) = rk[i];
    }
#pragma unroll
    for (int i = 0; i < NVL; ++i) {
      int c = tid + 256 * i;
      int row = c >> 2, cc = c & 3;
      *(u32x4*)(sv + row * 80 + cc * 16) = rv[i];
    }
    HBAR();
    const int kk = st < n1 ? st * 32 : lo2 + (st - n1) * 32;
    if (st + 1 < send) gload(st + 1);
    f32x16 x;
#pragma unroll
    for (int e = 0; e < 16; ++e) x[e] = 0.f;
    const char* pk = sk + r * KST + h * 16;
#pragma unroll
    for (int ks = 0; ks < DK / 16; ++ks) {
      bf16x8 a = *(const bf16x8*)(pk + ks * 32);
      x = MFMA32(a, qf[ks], x);
    }
    if (win && kk >= 256) {
      const int t = t0 + w * 32 + r;
      const int sb = kk - 256;
#pragma unroll
      for (int e = 0; e < 16; ++e) {
        int dlt = t - (sb + crow(e, h));
        if (dlt > 128 || dlt < -128) x[e] = -1e30f;
      }
    }
    float mloc = x[0];
#pragma unroll
    for (int e = 1; e < 16; ++e) mloc = fmaxf(mloc, x[e]);
    mloc = fmaxf(mloc, __shfl_xor(mloc, 32));
    const float mnew = fmaxf(mrun, mloc);
    const float alpha = __builtin_amdgcn_exp2f(mrun - mnew);
    mrun = mnew;
    float psum = 0.f;
#pragma unroll
    for (int e = 0; e < 16; ++e) { x[e] = __builtin_amdgcn_exp2f(x[e] - mnew); psum += x[e]; }
    lrun = lrun * alpha + psum;
#pragma unroll
    for (int d = 0; d < DV / 32; ++d)
#pragma unroll
      for (int e = 0; e < 16; ++e) o[d][e] *= alpha;
    bf16x8 pb0 = pack8(x[0], x[1], x[2], x[3], x[4], x[5], x[6], x[7]);
    bf16x8 pb1 = pack8(x[8], x[9], x[10], x[11], x[12], x[13], x[14], x[15]);
#pragma unroll
    for (int d = 0; d < DV / 32; ++d) {
      const char* pv = sv + (d * 32 + r) * 80 + h * 8;
      s16x4 lo0 = *(const s16x4*)(pv), hi0 = *(const s16x4*)(pv + 16);
      s16x4 lo1 = *(const s16x4*)(pv + 32), hi1 = *(const s16x4*)(pv + 48);
      bf16x8 av0 = __builtin_shufflevector(lo0, hi0, 0, 1, 2, 3, 4, 5, 6, 7);
      bf16x8 av1 = __builtin_shufflevector(lo1, hi1, 0, 1, 2, 3, 4, 5, 6, 7);
      o[d] = MFMA32(av0, pb0, o[d]);
      o[d] = MFMA32(av1, pb1, o[d]);
    }
  }
  if (split) {
    float* xch = (float*)(vh ? smem : smem + HALF_LDS);
    HBAR();
    if (vh == 1) {
#pragma unroll
      for (int d = 0; d < DV / 32; ++d)
#pragma unroll
        for (int e = 0; e < 16; ++e) xch[(d * 16 + e) * 256 + tid] = o[d][e];
      xch[(DV / 2) * 256 + tid] = mrun;
      xch[(DV / 2 + 1) * 256 + tid] = lrun;
    }
    __syncthreads();
    if (vh == 0) {
      const float m1 = xch[(DV / 2) * 256 + tid], l1 = xch[(DV / 2 + 1) * 256 + tid];
      const float mnew = fmaxf(mrun, m1);
      const float a0 = __builtin_amdgcn_exp2f(mrun - mnew), a1 = __builtin_amdgcn_exp2f(m1 - mnew);
      lrun = lrun * a0 + l1 * a1;
#pragma unroll
      for (int d = 0; d < DV / 32; ++d)
#pragma unroll
        for (int e = 0; e < 16; ++e) o[d][e] = o[d][e] * a0 + xch[(d * 16 + e) * 256 + tid] * a1;
    }
    __syncthreads();
    if (vh == 1) return;
  }
  const float ltot = lrun + __shfl_xor(lrun, 32);
  const float inv = 1.f / ltot;
  u16* op = O + (size_t)(m0 + w * 32 + r) * ldo + ooff;
#pragma unroll
  for (int d = 0; d < DV / 32; ++d)
#pragma unroll
    for (int g = 0; g < 4; ++g)
      *(uint2*)(op + d * 32 + 8 * g + 4 * h) = make_uint2(pack2(o[d][4 * g] * inv, o[d][4 * g + 1] * inv), pack2(o[d][4 * g + 2] * inv, o[d][4 * g + 3] * inv));
}

DI void hgrn_item(CP P, int kind, int idx, const u16* Qh, const u16* Vh, const f16* LF, u16* Oout, float* Lbuf, float* Dbuf, char* smem) {
  const int tid = (opq_full() & 255), lane = tid & 63, w = tid >> 6, r = lane & 31, h = lane >> 5;
  int S, mb, hh, dir, bp = 0, bl = 0, seg = 0, q = 0;
  if (kind == 0) { bp = idx >> 4; hh = (idx >> 1) & 7; dir = idx & 1; S = 256; mb = bp * 256; }
  else {
    if (kind == 1) { q = idx / 7; seg = idx - q * 7; } else { q = idx >> 3; seg = idx & 7; }
    bl = q >> 4; hh = (q >> 1) & 7; dir = q & 1; S = 2048; mb = MP + bl * 2048;
  }
  const int u0 = seg * 256;
  const bool write_o = kind != 1;
  char* Qs = smem;
  char* Ks = smem + 8704;
  char* KsT = smem + 17408;
  char* VT = smem + 27648;
  float* erho = (float*)(smem + 37888);
  float* elast = erho + 128;
  float* exch = elast + 128;
  const f16* lf_base = LF + (size_t)dir * MT * DM;
  u16* Od = Oout + (size_t)dir * MT * DM;

  f32x16 st[4];
  if (kind != 2) {
#pragma unroll
    for (int t = 0; t < 4; ++t)
#pragma unroll
      for (int e = 0; e < 16; ++e) st[t][e] = 0.f;
  } else {
    const float* s0 = P.in[4] + ((size_t)((bl * 2 + dir) * 8 + hh)) * 128 * 128;
#pragma unroll
    for (int t = 0; t < 4; ++t)
#pragma unroll
      for (int e = 0; e < 16; ++e) st[t][e] = s0[(size_t)(32 * t + crow(e, h)) * 128 + 32 * w + r];
#pragma unroll 1
    for (int j = 0; j < seg; ++j) {
      const float* Lj = Lbuf + (size_t)(q * 7 + j) * 16384;
      const float* Dj = Dbuf + (size_t)(q * 7 + j) * 128;
#pragma unroll
      for (int t = 0; t < 4; ++t)
#pragma unroll
        for (int g = 0; g < 4; ++g) {
          int k = 32 * t + 8 * g + 4 * h;
          float4 dj = *(const float4*)(Dj + k);
          const float* lp = Lj + (size_t)k * 128 + 32 * w + r;
          st[t][4 * g] = dj.x * st[t][4 * g] + lp[0];
          st[t][4 * g + 1] = dj.y * st[t][4 * g + 1] + lp[128];
          st[t][4 * g + 2] = dj.z * st[t][4 * g + 2] + lp[256];
          st[t][4 * g + 3] = dj.w * st[t][4 * g + 3] + lp[384];
        }
    }
  }
  float dlog = 0.f;
  const int kd = tid & 127, th = tid >> 7;
  const int nch = 8;
  typedef _Float16 f16x2 __attribute__((ext_vector_type(2)));
  typedef unsigned short u16x2 __attribute__((ext_vector_type(2)));
  f16x2 plf[8]; u16x2 pq[8], pv[8];
#pragma unroll
  for (int t16 = 0; t16 < 16; ++t16) {
    int t = th * 16 + t16;
    int tok = dir ? (S - 1 - (u0 + t)) : (u0 + t);
    size_t gi = (size_t)(mb + tok) * DM + hh * 128 + kd;
    plf[t16 >> 1][t16 & 1] = lf_base[gi]; pq[t16 >> 1][t16 & 1] = Qh[gi]; pv[t16 >> 1][t16 & 1] = Vh[gi];
  }
  for (int c = 0; c < nch; ++c) {
    HBAR();
    float bc[16];
    float run = 0.f;
#pragma unroll
    for (int t16 = 0; t16 < 16; ++t16) {
      run += (float)plf[t16 >> 1][t16 & 1];
      bc[t16] = run;
    }
    if (th == 0) exch[kd] = run;
    HBAR();
    const float rho = exch[kd];
    if (th == 1) {
#pragma unroll
      for (int t16 = 0; t16 < 16; ++t16) bc[t16] += rho;
      elast[kd] = __expf(bc[15] - rho);
      erho[kd] = __expf(rho);
      dlog += bc[15];
    }
#pragma unroll
    for (int t16 = 0; t16 < 16; ++t16) {
      int t = th * 16 + t16;
      float q = bf2f(pq[t16 >> 1][t16 & 1]);
      float kval = 1.f - __expf((float)plf[t16 >> 1][t16 & 1]);
      float dq = bc[t16] - rho;
      u16 qb = f2bf(q * __expf(dq));
      u16 kb = f2bf(kval * __expf(-dq));
      *(u16*)(Qs + t * 272 + kd * 2) = qb;
      *(u16*)(Ks + t * 272 + kd * 2) = kb;
      *(u16*)(KsT + kd * 80 + t * 2) = kb;
      *(u16*)(VT + kd * 80 + t * 2) = pv[t16 >> 1][t16 & 1];
    }
    if (c + 1 < nch) {
#pragma unroll
      for (int t16 = 0; t16 < 16; ++t16) {
        int t = th * 16 + t16;
        int tok = dir ? (S - 1 - (u0 + (c + 1) * 32 + t)) : (u0 + (c + 1) * 32 + t);
        size_t gi = (size_t)(mb + tok) * DM + hh * 128 + kd;
        plf[t16 >> 1][t16 & 1] = lf_base[gi]; pq[t16 >> 1][t16 & 1] = Qh[gi]; pv[t16 >> 1][t16 & 1] = Vh[gi];
      }
    }
    HBAR();
#pragma unroll
    for (int t = 0; t < 4; ++t)
#pragma unroll
      for (int g = 0; g < 4; ++g) {
        float4 er = *(const float4*)(erho + 32 * t + 8 * g + 4 * h);
        st[t][4 * g] *= er.x; st[t][4 * g + 1] *= er.y; st[t][4 * g + 2] *= er.z; st[t][4 * g + 3] *= er.w;
      }
    if (write_o) {
      f32x16 x;
#pragma unroll
      for (int e = 0; e < 16; ++e) x[e] = 0.f;
#pragma unroll
      for (int ks = 0; ks < 8; ++ks) {
        bf16x8 a = *(const bf16x8*)(Ks + r * 272 + ks * 32 + h * 16);
        bf16x8 b = *(const bf16x8*)(Qs + r * 272 + ks * 32 + h * 16);
        x = MFMA32(a, b, x);
      }
#pragma unroll
      for (int e = 0; e < 16; ++e) if (crow(e, h) > r) x[e] = 0.f;
      f32x16 oacc;
#pragma unroll
      for (int e = 0; e < 16; ++e) oacc[e] = 0.f;
#pragma unroll
      for (int t = 0; t < 4; ++t) {
        bf16x8 sb0 = pack8(st[t][0], st[t][1], st[t][2], st[t][3], st[t][4], st[t][5], st[t][6], st[t][7]);
        bf16x8 sb1 = pack8(st[t][8], st[t][9], st[t][10], st[t][11], st[t][12], st[t][13], st[t][14], st[t][15]);
        const char* pq = Qs + r * 272 + (32 * t + 4 * h) * 2;
        s16x4 lo0 = *(const s16x4*)(pq), hi0 = *(const s16x4*)(pq + 16);
        s16x4 lo1 = *(const s16x4*)(pq + 32), hi1 = *(const s16x4*)(pq + 48);
        bf16x8 qa0 = __builtin_shufflevector(lo0, hi0, 0, 1, 2, 3, 4, 5, 6, 7);
        bf16x8 qa1 = __builtin_shufflevector(lo1, hi1, 0, 1, 2, 3, 4, 5, 6, 7);
        oacc = MFMA32(qa0, sb0, oacc);
        oacc = MFMA32(qa1, sb1, oacc);
      }
      {
        bf16x8 xa0 = pack8(x[0], x[1], x[2], x[3], x[4], x[5], x[6], x[7]);
        bf16x8 xa1 = pack8(x[8], x[9], x[10], x[11], x[12], x[13], x[14], x[15]);
        const char* pv = VT + (32 * w + r) * 80 + h * 8;
        s16x4 lo0 = *(const s16x4*)(pv), hi0 = *(const s16x4*)(pv + 16);
        s16x4 lo1 = *(const s16x4*)(pv + 32), hi1 = *(const s16x4*)(pv + 48);
        bf16x8 vb0 = __builtin_shufflevector(lo0, hi0, 0, 1, 2, 3, 4, 5, 6, 7);
        bf16x8 vb1 = __builtin_shufflevector(lo1, hi1, 0, 1, 2, 3, 4, 5, 6, 7);
        oacc = MFMA32(xa0, vb0, oacc);
        oacc = MFMA32(xa1, vb1, oacc);
      }
#pragma unroll
      for (int e = 0; e < 16; ++e) {
        int t = crow(e, h);
        int tok = dir ? (S - 1 - (u0 + c * 32 + t)) : (u0 + c * 32 + t);
        Od[(size_t)(mb + tok) * DM + hh * 128 + 32 * w + r] = f2bf(oacc[e]);
      }
    }
    {
      const char* pv = VT + (32 * w + r) * 80 + h * 16;
      bf16x8 vn0 = *(const bf16x8*)(pv), vn1 = *(const bf16x8*)(pv + 32);
#pragma unroll
      for (int t = 0; t < 4; ++t) {
        const char* pk = KsT + (32 * t + r) * 80 + h * 16;
        bf16x8 ka0 = *(const bf16x8*)(pk), ka1 = *(const bf16x8*)(pk + 32);
        st[t] = MFMA32(ka0, vn0, st[t]);
        st[t] = MFMA32(ka1, vn1, st[t]);
#pragma unroll
        for (int g = 0; g < 4; ++g) {
          float4 el = *(const float4*)(elast + 32 * t + 8 * g + 4 * h);
          st[t][4 * g] *= el.x; st[t][4 * g + 1] *= el.y; st[t][4 * g + 2] *= el.z; st[t][4 * g + 3] *= el.w;
        }
      }
    }
  }
  if (kind == 0) {
    float* so = P.out + OUT_HG + ((size_t)((bp * 2 + dir) * 8 + hh)) * 128 * 128;
#pragma unroll
    for (int t = 0; t < 4; ++t)
#pragma unroll
      for (int e = 0; e < 16; ++e) so[(size_t)(32 * t + crow(e, h)) * 128 + 32 * w + r] = st[t][e];
  } else if (kind == 1) {
    float* so = Lbuf + (size_t)idx * 16384;
#pragma unroll
    for (int t = 0; t < 4; ++t)
#pragma unroll
      for (int e = 0; e < 16; ++e) so[(size_t)(32 * t + crow(e, h)) * 128 + 32 * w + r] = st[t][e];
    if (th == 1) Dbuf[(size_t)idx * 128 + kd] = __expf(dlog);
  }
}

DI void gemm_residual_phase(CP P, const u16* A, int K, const u16* Bt, int layer, int which  , char* smem) {
  const int tiles = (MT / 256) * (DM / 256);
  for (int t = blockIdx.x; t < tiles; t += gridDim.x) {
    int tm = t % (MT / 256), tn = t / (MT / 256);
    gemm_tile<4>(A, K, Bt, K, K, tm * 256, tn * 256, smem, [&](int m, int n, float4 vA, float4 vB) {
      const float* gate = P.mod + (size_t)(layer * 3 + grp_of(m)) * 6144 + which * 1024;
      float gA = gate[n], gB = gate[n + 32];
#pragma unroll
      for (int e = 0; e < 4; ++e) {
        u16* xp = P.X + (size_t)(m + e) * DM + n;
        xp[0] = f2bf(bf2f(xp[0]) + gA * f4get(vA, e));
        xp[32] = f2bf(bf2f(xp[32]) + gB * f4get(vB, e));
      }
    });
  }
}

DI void ffn_block(CP P, const XcdBarrier& xb, int layer, char* smem) {
  u16* H = (u16*)P.arena;
  u16* ACT = (u16*)(P.arena + (size_t)24 * 1048576);
  normmod_phase(P, layer, 1, P.in[12] + layer * DM, H);
  xcd_barrier(xb);
  {
    const u16* Bt = P.Wgu + (size_t)layer * 5632 * DM;
    auto epi_gu = [&](int m, int n, float4 vA, float4 vB) {
      int ff = (n >> 6) * 32 + (n & 31);
#pragma unroll
      for (int e = 0; e < 4; ++e) ACT[(size_t)(m + e) * DFF + ff] = f2bf(silu_f(f4get(vA, e)) * f4get(vB, e));
    };
    for (int t = blockIdx.x; t < 1024; t += gridDim.x) {
      int tm = t % (MT / 256), tn = t / (MT / 256);
      gemm_tile<4>(H, DM, Bt, DM, DM, tm * 256, tn * 256, smem, epi_gu);
    }
    for (int u = blockIdx.x; u < 64; u += gridDim.x) {
      int ft = 1024 + (u >> 1);
      int tm = ft % (MT / 256), tn = ft / (MT / 256);
      gemm_tile<2>(H, DM, Bt, DM, DM, tm * 256, tn * 256 + (u & 1) * 128, smem, epi_gu);
    }
  }
  xcd_barrier(xb);
  gemm_residual_phase(P, ACT, DFF, P.Wd + (size_t)layer * DM * DFF, layer, 5, smem);
  xcd_barrier(xb);
}

DI void store_vt4(u16* p, float4 v) { *(uint2*)p = make_uint2(pack2(v.x, v.y), pack2(v.z, v.w)); }

DI void mla_layer(CP P, const XcdBarrier& xb, int layer, int j, char* smem) {
  const size_t MiB = 1048576;
  u16* H = (u16*)P.arena;
  u16* RAW = (u16*)(P.arena + 24 * MiB);
  u16* QN = (u16*)(P.arena + 63 * MiB);
  u16* Q = (u16*)(P.arena + 75 * MiB);
  u16* Kn = (u16*)(P.arena + 111 * MiB);
  u16* VtP = (u16*)(P.arena + 136 * MiB);
  u16* VtS = (u16*)(P.arena + 152 * MiB);
  u16* O = (u16*)(P.arena + 161 * MiB);
  u16* CK = P.CKVk + (size_t)j * KROWS * 256;
  u16* KR = P.KRk + (size_t)j * KROWS * 64;
  normmod_phase(P, layer, 0, P.in[11] + layer * DM, H, layer == 0);
  xcd_barrier(xb);
  {
    const u16* Bt = P.Wdqkv + (size_t)j * 1024 * DM;
    const int tiles = (MT / 256) * 4;
    for (int t = blockIdx.x; t < tiles; t += gridDim.x) {
      int tm = t % (MT / 256), tn = t / (MT / 256);
      gemm_tile<4>(H, DM, Bt, DM, DM, tm * 256, tn * 256, smem, [&](int m, int n, float4 vA, float4 vB) {
#pragma unroll
        for (int e = 0; e < 4; ++e) {
          if (n < 832) RAW[(size_t)(m + e) * 832 + n] = f2bf(f4get(vA, e));
          if (n + 32 < 832) RAW[(size_t)(m + e) * 832 + n + 32] = f2bf(f4get(vB, e));
        }
      });
    }
  }
  xcd_barrier(xb);
  mla_rownorm_phase(P, j, RAW, QN);
  xcd_barrier(xb);
  {
    const u16* Bq = P.Wuq + (size_t)j * 1536 * 512;
    const u16* Bkv = P.Wukv + (size_t)j * 2048 * 256;
    const int T1 = (MT / 256) * 6, T2 = (KROWS / 256) * 8;
    const float qs = 0.07216878364870322f * LOG2E;
    for (int t = blockIdx.x; t < T1 + T2; t += gridDim.x) {
      const bool isq = t < T1;
      int tm, tn; const u16 *Ap, *Bp; int kdim;
      if (isq) { tm = t % (MT / 256); tn = t / (MT / 256); Ap = QN; Bp = Bq; kdim = 512; }
      else { int t2 = t - T1; tm = t2 % (KROWS / 256); tn = t2 / (KROWS / 256); Ap = CK; Bp = Bkv; kdim = 256; }
      gemm_tile<4>(Ap, kdim, Bp, kdim, kdim, tm * 256, tn * 256, smem, [&](int m, int n, float4 vA, float4 vB) {
        if (isq) {
          auto one = [&](int nn, float4 v) {
            int d = nn % 192;
            bool rp = (d >= 128) && (m >= MP);
#pragma unroll
            for (int e = 0; e < 4; ++e) {
              float val = f4get(v, e);
              if (rp) {
                float partner = __shfl_xor(val, 16);
                val = rope1(val, partner, d - 128, (m + e - MP) & 2047);
              }
              Q[(size_t)(m + e) * 1536 + nn] = f2bf(val * qs);
            }
          };
          one(n, vA);
          one(n + 32, vB);
        } else {
          const int R = m;
          auto one = [&](int nn, float4 v) {
            if (nn < 1024) {
#pragma unroll
              for (int e = 0; e < 4; ++e) Kn[(size_t)(R + e) * 1024 + nn] = f2bf(f4get(v, e));
            } else {
              int c = nn - 1024, hh = c >> 7, dv = c & 127;
              if (R < MP) {
                int b = R >> 8, s = R & 255;
                store_vt4(VtP + ((size_t)(b * 8 + hh) * 128 + dv) * 256 + s, v);
              } else {
                int Rp = R - MP; int b = Rp / 2304; int kk = Rp - b * 2304;
                store_vt4(VtS + ((size_t)(b * 8 + hh) * 128 + dv) * 2304 + kk, v);
              }
            }
          };
          one(n, vA);
          one(n + 32, vB);
        }
      });
    }
  }
  xcd_barrier(xb);
  {
    const int NL = 256, NP = 512;
    const int lat_rounds = (NL + (int)gridDim.x - 1) / (int)gridDim.x, pr_rounds = (NP + VGRID - 1) / VGRID;
    for (int j = 0; j < lat_rounds + pr_rounds; ++j) {
      const bool split = j < lat_rounds;
      int b, hh, m0, kbase, ldv, e1; const u16* vt;
      if (split) {
        const int it = (int)blockIdx.x + j * (int)gridDim.x;
        if (it >= NL) continue;
        b = it >> 7; hh = (it >> 4) & 7; int qb = it & 15;
        m0 = MP + b * 2048 + qb * 128; kbase = MP + b * 2304; ldv = 2304; e1 = 2304;
        vt = VtS + (size_t)(b * 8 + hh) * 128 * 2304;
      } else {
        const int i2 = VBLK + (j - lat_rounds) * VGRID;
        if (i2 >= NP) continue;
        b = i2 >> 4; hh = (i2 >> 1) & 7; int qb = i2 & 1;
        m0 = b * 256 + qb * 128; kbase = b * 256; ldv = 256; e1 = 256;
        vt = VtP + (size_t)(b * 8 + hh) * 128 * 256;
      }
      attn_item<128, 64, 128>(Q, 1536, hh * 192, m0, Kn, 1024, hh * 128, KR, kbase, vt, ldv, e1, 0, 0, false, 0, -1e30f, 0.f,
                              O, DM, hh * 128, smem + VHALF * HALF_LDS, split);
    }
  }
  xcd_barrier(xb);
  gemm_residual_phase(P, O, DM, P.Wmo + (size_t)j * DM * DM, layer, 2, smem);
  xcd_barrier(xb);
}

DI void hgrn_layer(CP P, const XcdBarrier& xb, int layer, char* smem) {
  const size_t MiB = 1048576;
  u16* H = (u16*)P.arena;
  u16* Qh = (u16*)(P.arena + 24 * MiB);
  u16* Vh = (u16*)(P.arena + 48 * MiB);
  u16* Gh = (u16*)(P.arena + 72 * MiB);
  f16* LF = (f16*)(P.arena + 96 * MiB);
  u16* OO = (u16*)(P.arena + 144 * MiB);
  normmod_phase(P, layer, 0, P.in[11] + layer * DM, H);
  xcd_barrier(xb);
  {
    const int tiles = (MT / 256) * 20;
    for (int t = blockIdx.x; t < tiles; t += gridDim.x) {
      int tm = t % (MT / 256), tn = t / (MT / 256);
      gemm_tile<4>(H, DM, P.Wh, DM, DM, tm * 256, tn * 256, smem, [&](int m, int n, float4 vA, float4 vB) {
        const int seg = n >> 10;
        const int c = n & 1023;
        const unsigned gi = (unsigned)m * DM + c;
        if (seg == 0 || seg == 4) {
          u16* dst = seg == 0 ? Qh : Gh;
#pragma unroll
          for (int e = 0; e < 4; ++e) {
            dst[gi + e * DM] = f2bf(silu_f(f4get(vA, e)));
            dst[gi + e * DM + 32] = f2bf(silu_f(f4get(vB, e)));
          }
        } else if (seg == 3) {
#pragma unroll
          for (int e = 0; e < 4; ++e) {
            Vh[gi + e * DM] = f2bf(f4get(vA, e));
            Vh[gi + e * DM + 32] = f2bf(f4get(vB, e));
          }
        } else {
          const float lbA = P.lb[(seg - 1) * 1024 + c], lbB = P.lb[(seg - 1) * 1024 + c + 32];
          f16* lf = LF + (size_t)(seg - 1) * MT * DM;
#pragma unroll
          for (int e = 0; e < 4; ++e) {
            float fA = lbA + (1.f - lbA) * sigmoid_f(f4get(vA, e));
            float fB = lbB + (1.f - lbB) * sigmoid_f(f4get(vB, e));
            lf[gi + e * DM] = (f16)__logf(fA);
            lf[gi + e * DM + 32] = (f16)__logf(fB);
          }
        }
      });
    }
  }
  xcd_barrier(xb);
  float* Lbuf = (float*)P.arena;
  float* Dbuf = (float*)(P.arena + (size_t)15 * MiB);
  for (int ph = 0; ph < 2; ++ph) {
    const int nit = ph == 0 ? 512 : 480;
    for (int it = VBLK; it < nit; it += VGRID) {
      int kind, idx;
      if (ph == 0) { if (it < 224) { kind = 1; idx = it; } else { kind = 0; idx = it - 224; } }
      else { if (it < 256) { kind = 2; idx = it; } else { kind = 0; idx = it - 256 + 288; } }
      hgrn_item(P, kind, idx, Qh, Vh, LF, OO, Lbuf, Dbuf, smem + VHALF * HALF_LDS);
    }
    xcd_barrier(xb);
  }
  hgrn_post_phase(P, OO, OO + (size_t)MT * DM, Gh, H);
  xcd_barrier(xb);
  gemm_residual_phase(P, H, DM, P.Who, layer, 2, smem);
  xcd_barrier(xb);
}

DI void swa_layer(CP P, const XcdBarrier& xb, int layer, char* smem) {
  const size_t MiB = 1048576;
  u16* H = (u16*)P.arena;
  u16* Q = (u16*)(P.arena + 24 * MiB);
  u16* VtP2 = (u16*)(P.arena + 48 * MiB);
  u16* O = (u16*)(P.arena + 52 * MiB);
  normmod_phase(P, layer, 0, P.in[11] + layer * DM, H);
  xcd_barrier(xb);
  {
    const int tiles = (MT / 256) * 6;
    const float qs = 0.125f * LOG2E;
    for (int t = blockIdx.x; t < tiles; t += gridDim.x) {
      int tm = t % (MT / 256), tn = t / (MT / 256);
      gemm_tile<4>(H, DM, P.Wsqkv, DM, DM, tm * 256, tn * 256, smem, [&](int m, int n, float4 vA, float4 vB) {
        auto one = [&](int nn, float4 v) {
          const bool lat = m >= MP;
          if (nn < 1280) {
            const bool isq = nn < 1024;
#pragma unroll
            for (int e = 0; e < 4; ++e) {
              float val = f4get(v, e);
              if (!isq && !lat) P.out[OUT_SK + (size_t)(m + e) * 256 + (nn - 1024)] = val;
              if (lat) {
                float partner = __shfl_xor(val, 16);
                val = rope1(val, partner, nn & 63, (m + e - MP) & 2047);
              }
              if (isq) Q[(size_t)(m + e) * DM + nn] = f2bf(val * qs);
              else P.KSk[(size_t)keyrow_of(m + e) * 256 + (nn - 1024)] = f2bf(val);
            }
          } else {
            int c = nn - 1280, kvh = c >> 6, d = c & 63;
            if (!lat) {
#pragma unroll
              for (int e = 0; e < 4; ++e) P.out[OUT_SV + (size_t)(m + e) * 256 + c] = f4get(v, e);
              int b = m >> 8, s = m & 255;
              store_vt4(VtP2 + ((size_t)(b * 4 + kvh) * 64 + d) * 256 + s, v);
            } else {
              int mm = m - MP; int b = mm >> 11, s = mm & 2047;
              store_vt4(P.VtS2 + ((size_t)(b * 4 + kvh) * 64 + d) * 2304 + 256 + s, v);
            }
          }
        };
        one(n, vA);
        one(n + 32, vB);
      });
    }
  }
  xcd_barrier(xb);
  {
    const int NL = 512, NP = 1024;
    for (int it = VBLK; it < NL + NP; it += VGRID) {
      int b, hq, m0, kbase, ldv, lo2 = 0, hi2 = 0, t0 = 0; bool win = false; const u16* vt;
      if (it < NL) {
        b = it >> 8; hq = (it >> 4) & 15; int qb = it & 15;
        t0 = qb * 128;
        int lo = t0 - 128 < 0 ? 0 : t0 - 128;
        int hi = t0 + 256 > 2048 ? 2048 : t0 + 256;
        lo2 = 256 + lo; hi2 = 256 + hi; win = true;
        m0 = MP + b * 2048 + t0; kbase = MP + b * 2304; ldv = 2304;
        vt = P.VtS2 + (size_t)(b * 4 + (hq >> 2)) * 64 * 2304;
      } else {
        int i2 = it - NL;
        b = i2 >> 5; hq = (i2 >> 1) & 15; int qb = i2 & 1;
        m0 = b * 256 + qb * 128; kbase = b * 256; ldv = 256;
        vt = VtP2 + (size_t)(b * 4 + (hq >> 2)) * 64 * 256;
      }
      float sink = P.in[36][hq] * LOG2E;
      attn_item<64, 0, 64>(Q, DM, hq * 64, m0, P.KSk, 256, (hq >> 2) * 64, nullptr, kbase, vt, ldv, 256, lo2, hi2, win, t0, sink, 1.f,
                           O, DM, hq * 64, smem + VHALF * HALF_LDS);
    }
  }
  xcd_barrier(xb);
  gemm_residual_phase(P, O, DM, P.Wso, layer, 2, smem);
  xcd_barrier(xb);
}

__global__ void __launch_bounds__(512, 2) hybrid_mega(Params Pval) {
  CP P = *(const __attribute__((address_space(4))) Params*)__builtin_amdgcn_kernarg_segment_ptr();
  __shared__ __attribute__((aligned(16))) char smem[SMEM_BYTES];
  if (threadIdx.x < 64) g_hbar[threadIdx.x] = 0u;
  g_tidtab[threadIdx.x] = threadIdx.x;
  __shared__ uint4 xb_words;
  cg::grid_group grid = cg::this_grid();
  if (threadIdx.x == 0) xb_words = make_uint4(0u, 0u, 0u, 0u);
  __syncthreads();
  const XcdBarrier xb = xcd_barrier_post(P.bar, (volatile LAS unsigned*)&xb_words);
  phase0(P, smem + VHALF * HALF_LDS);
  grid.sync();
  mla_layer(P, xb, 0, 0, smem);
  ffn_block(P, xb, 0, smem);
  hgrn_layer(P, xb, 1, smem);
  ffn_block(P, xb, 1, smem);
  swa_layer(P, xb, 2, smem);
  ffn_block(P, xb, 2, smem);
  mla_layer(P, xb, 3, 1, smem);
  ffn_block(P, xb, 3, smem);
  final_norm_phase(P);
}

extern "C" void kernel_launch(void* const* d_in, const int* in_sizes, int n_in, void* d_out, int out_size, void* d_ws, size_t ws_size,
                              hipStream_t stream) {
  static int grid_blocks = 0;
  if (!grid_blocks) {
    int dev = 0, cus = 0, per_cu = 0;
    hipGetDevice(&dev);
    hipDeviceGetAttribute(&cus, hipDeviceAttributeMultiprocessorCount, dev);
    hipOccupancyMaxActiveBlocksPerMultiprocessor(&per_cu, hybrid_mega, 512, 0);
    if (per_cu > 1) per_cu = 1;
    grid_blocks = cus * per_cu;
  }
  Params P{};
  for (int i = 0; i < 37; ++i) P.in[i] = (const float*)d_in[i];
  P.out = (float*)d_out;
  char* ws = (char*)d_ws;
  size_t off = 0;
  auto alloc = [&](size_t bytes) { size_t o = off; off += (bytes + 255) & ~(size_t)255; return ws + o; };
  P.Wgu = (u16*)alloc((size_t)4 * 5632 * DM * 2);
  P.Wd = (u16*)alloc((size_t)4 * DM * DFF * 2);
  P.Wdqkv = (u16*)alloc((size_t)2 * 1024 * DM * 2);
  P.Wuq = (u16*)alloc((size_t)2 * 1536 * 512 * 2);
  P.Wukv = (u16*)alloc((size_t)2 * 2048 * 256 * 2);
  P.Wmo = (u16*)alloc((size_t)2 * DM * DM * 2);
  P.Wh = (u16*)alloc((size_t)5120 * DM * 2);
  P.Who = (u16*)alloc((size_t)DM * DM * 2);
  P.Wsqkv = (u16*)alloc((size_t)1536 * DM * 2);
  P.Wso = (u16*)alloc((size_t)DM * DM * 2);
  P.X = (u16*)alloc((size_t)MT * DM * 2);
  P.mod = (float*)alloc((size_t)4 * 3 * 6144 * 4);
  P.lb = (float*)alloc(2048 * 4);
  P.CKVk = (u16*)alloc((size_t)2 * KROWS * 256 * 2);
  P.KRk = (u16*)alloc((size_t)2 * KROWS * 64 * 2);
  P.KSk = (u16*)alloc((size_t)KROWS * 256 * 2);
  P.VtS2 = (u16*)alloc((size_t)2 * 4 * 64 * 2304 * 2);
  P.arena = alloc((size_t)192 * 1048576);
  P.bar = (unsigned*)alloc(XCD_BAR_WORDS * 4);
  if (off > ws_size) { fprintf(stderr, "workspace too small: need %zu have %zu\n", off, ws_size); return; }
  hipMemsetAsync(P.bar, 0, XCD_BAR_WORDS * 4, stream);
  void* args[] = {&P};
  hipError_t e = hipLaunchCooperativeKernel((void*)hybrid_mega, dim3(grid_blocks), dim3(512), args, 0, stream);
  if (e != hipSuccess) fprintf(stderr, "cooperative launch failed: %s (grid %d)\n", hipGetErrorString(e), grid_blocks);
}
```
